# Optimizing an MI355X kernel written in HIP

```python
import math
import jax, jax.numpy as jnp
from jax import lax
import numpy as np

D_MODEL = 1024
BATCH = 1
SEQ = 16384
DEPTH = 2

D_PLE = 256
D_MIX = D_MODEL
ATTN_WIDTH = D_MIX // 2
N_DIFF_HEADS = 4
DIFF_V_DIM = ATTN_WIDTH // N_DIFF_HEADS
DIFF_QK_DIM = DIFF_V_DIM // 2
CONV_WIDTH = D_MIX - ATTN_WIDTH
N_CONV_GROUPS = 8
CONV_GROUP_DIM = CONV_WIDTH // N_CONV_GROUPS
CONV_K = 3
D_IN = 3 * ATTN_WIDTH + 3 * CONV_WIDTH
D_FF = 2816
Q_BLOCK = 128
EPS = 1e-6

kernel_name = "hymba_diffattn_shortconv_macaron_ple"


def rmsnorm(x, g):
    xf = x.astype(jnp.float32)
    y = xf * lax.rsqrt(jnp.mean(xf * xf, axis=-1, keepdims=True) + EPS)
    return (y * g.astype(jnp.float32)).astype(x.dtype)


def swiglu(x, w_gate, w_up, w_down):
    return (jax.nn.silu(x @ w_gate) * (x @ w_up)) @ w_down


def causal_diff_attention(q, k, v, lam):
    b, s, h, dv = v.shape
    n_blocks = s // Q_BLOCK
    scale = 1.0 / math.sqrt(DIFF_QK_DIM)
    k_pos = jnp.arange(s)

    def block(i):
        start = i * Q_BLOCK
        qb = lax.dynamic_slice_in_dim(q, start, Q_BLOCK, axis=1)
        sc = jnp.einsum('bqhmd,bkhmd->bhmqk', qb, k).astype(jnp.float32) * scale
        q_pos = start + jnp.arange(Q_BLOCK)
        mask = k_pos[None, :] <= q_pos[:, None]
        sc = jnp.where(mask, sc, -jnp.inf)
        a = jax.nn.softmax(sc, axis=-1)
        diff = a[:, :, 0] - lam * a[:, :, 1]
        return jnp.einsum('bhqk,bkhe->bqhe', diff.astype(v.dtype), v)

    out = lax.map(block, jnp.arange(n_blocks))
    return jnp.transpose(out, (1, 0, 2, 3, 4)).reshape(b, s, h, dv)


def causal_dwconv(u, w, bias):
    c = u.shape[-1]
    y = lax.conv_general_dilated(
        u, w[:, None, :].astype(u.dtype), window_strides=(1,),
        padding=[(CONV_K - 1, 0)], dimension_numbers=('NWC', 'WIO', 'NWC'),
        feature_group_count=c)
    return y + bias


def setup_inputs(seed: int = 0) -> dict:
    key = jax.random.key(seed)
    ks = iter(jax.random.split(key, 32))

    def nrm(shape, scale):
        return jax.random.normal(next(ks), shape, jnp.float32) * scale

    def gain(shape):
        return 1.0 + nrm(shape, 0.01)

    return {
        "x": nrm((BATCH, SEQ, D_MODEL), 1.0),
        "p": nrm((DEPTH, BATCH, SEQ, D_PLE), 1.0),
        "ffn1_norm": gain((DEPTH, D_MODEL)),
        "ffn1_w_gate": nrm((DEPTH, D_MODEL, D_FF), D_MODEL ** -0.5),
        "ffn1_w_up": nrm((DEPTH, D_MODEL, D_FF), D_MODEL ** -0.5),
        "ffn1_w_down": nrm((DEPTH, D_FF, D_MODEL), D_FF ** -0.5),
        "mix_norm": gain((DEPTH, D_MODEL)),
        "w_in": nrm((DEPTH, D_MODEL, D_IN), D_MODEL ** -0.5),
        "q_norm": gain((DEPTH, DIFF_QK_DIM)),
        "k_norm": gain((DEPTH, DIFF_QK_DIM)),
        "lambda_q1": nrm((DEPTH, DIFF_QK_DIM), 0.1),
        "lambda_k1": nrm((DEPTH, DIFF_QK_DIM), 0.1),
        "lambda_q2": nrm((DEPTH, DIFF_QK_DIM), 0.1),
        "lambda_k2": nrm((DEPTH, DIFF_QK_DIM), 0.1),
        "attn_out_norm": gain((DEPTH, DIFF_V_DIM)),
        "conv_w": nrm((DEPTH, CONV_K, CONV_WIDTH), CONV_K ** -0.5),
        "conv_b": nrm((DEPTH, CONV_WIDTH), 0.01),
        "conv_out_norm": gain((DEPTH, CONV_WIDTH)),
        "w_out": nrm((DEPTH, D_MIX, D_MODEL), D_MIX ** -0.5),
        "ffn2_norm": gain((DEPTH, D_MODEL)),
        "ffn2_w_gate": nrm((DEPTH, D_MODEL, D_FF), D_MODEL ** -0.5),
        "ffn2_w_up": nrm((DEPTH, D_MODEL, D_FF), D_MODEL ** -0.5),
        "ffn2_w_down": nrm((DEPTH, D_FF, D_MODEL), D_FF ** -0.5),
        "ple_norm": gain((DEPTH, D_MODEL)),
        "ple_w_gate": nrm((DEPTH, D_MODEL, D_MODEL), D_MODEL ** -0.5),
        "ple_w_proj": nrm((DEPTH, D_PLE, D_MODEL), D_PLE ** -0.5),
    }


def reference(x, p, ffn1_norm, ffn1_w_gate, ffn1_w_up, ffn1_w_down,
              mix_norm, w_in, q_norm, k_norm,
              lambda_q1, lambda_k1, lambda_q2, lambda_k2, attn_out_norm,
              conv_w, conv_b, conv_out_norm, w_out,
              ffn2_norm, ffn2_w_gate, ffn2_w_up, ffn2_w_down,
              ple_norm, ple_w_gate, ple_w_proj):
    b, s, _ = x.shape
    splits = [ATTN_WIDTH, 2 * ATTN_WIDTH, 3 * ATTN_WIDTH,
              3 * ATTN_WIDTH + CONV_WIDTH, 3 * ATTN_WIDTH + 2 * CONV_WIDTH]
    for i in range(DEPTH):
        lam_init = 0.8 - 0.6 * math.exp(-0.3 * i)

        x = x + 0.5 * swiglu(rmsnorm(x, ffn1_norm[i]), ffn1_w_gate[i], ffn1_w_up[i], ffn1_w_down[i])

        h = rmsnorm(x, mix_norm[i])
        z = h @ w_in[i]
        q, k, v, g_b, g_c, hc = jnp.split(z, splits, axis=-1)

        q = rmsnorm(q.reshape(b, s, N_DIFF_HEADS, 2, DIFF_QK_DIM), q_norm[i])
        k = rmsnorm(k.reshape(b, s, N_DIFF_HEADS, 2, DIFF_QK_DIM), k_norm[i])
        v = v.reshape(b, s, N_DIFF_HEADS, DIFF_V_DIM)
        lam = (jnp.exp(jnp.sum(lambda_q1[i].astype(jnp.float32) * lambda_k1[i].astype(jnp.float32)))
               - jnp.exp(jnp.sum(lambda_q2[i].astype(jnp.float32) * lambda_k2[i].astype(jnp.float32)))
               + lam_init)
        o = causal_diff_attention(q, k, v, lam)
        o = (rmsnorm(o, attn_out_norm[i]) * (1.0 - lam_init)).reshape(b, s, ATTN_WIDTH)

        yc = g_b * causal_dwconv(g_c * hc, conv_w[i], conv_b[i])
        yc = rmsnorm(yc.reshape(b, s, N_CONV_GROUPS, CONV_GROUP_DIM),
                     conv_out_norm[i].reshape(N_CONV_GROUPS, CONV_GROUP_DIM)).reshape(b, s, CONV_WIDTH)

        x = x + jnp.concatenate([o, yc], axis=-1) @ w_out[i]

        x = x + 0.5 * swiglu(rmsnorm(x, ffn2_norm[i]), ffn2_w_gate[i], ffn2_w_up[i], ffn2_w_down[i])

        gate = jax.nn.sigmoid(rmsnorm(x, ple_norm[i]) @ ple_w_gate[i])
        x = x + gate * (p[i] @ ple_w_proj[i])
    return x
```

```cpp
#include <hip/hip_runtime.h>
#include <hip/hip_cooperative_groups.h>
#include <cstdio>
#include <cstdint>
namespace cg = cooperative_groups;
namespace pg8 {
#define PG8_LAS __attribute__((address_space(3)))
typedef unsigned short bf16_t;
typedef short bf16x8 __attribute__((ext_vector_type(8)));
typedef float f32x4 __attribute__((ext_vector_type(4)));
typedef unsigned u32x4 __attribute__((ext_vector_type(4)));
constexpr int BM = 256, BK = 64, HALF = 128, HTB = HALF * BK * 2  , STAGE_BYTES = 8 * HTB, NXCD = 8, WGM = 8;

__host__ __device__ __forceinline__ int lds_byte(int r, int c) { const int st = (r >> 4) * 2 + (c >> 5), rr = r & 15, cc = c & 31, ob = rr * 64 + cc * 2; return st * 1024 + (ob ^ (((ob >> 9) & 1) << 5)); }
__host__ __device__ __forceinline__ void stage_rc(int b, int& R, int& C) { const int st = b / 1024, sb = b % 1024, swz = sb ^ (((sb >> 9) & 1) << 5); R = (st >> 1) * 16 + swz / 64; C = (st & 1) * 32 + (swz % 64) / 2; }
__host__ __device__ __forceinline__ int perm32(int rho) { const int n = rho >> 4, i = rho & 15; return 8 * (i >> 2) + 4 * n + (i & 3); }

struct Unit { int pm, pn; };
struct Gemm { const bf16_t* A; const bf16_t* Bt; int M, N, K; };

struct StaticOrder {
    int nM, nN, nwg, G, c;
    __host__ __device__ void init(int M, int N, int G_, int c_) { nM = M / BM; nN = N / BM; nwg = nM * nN; G = G_; c = c_; }
    __host__ __device__ bool next(int i, Unit& u) const {
        const long L = (long)i * G + c; if (L >= nwg) return false;
        int wgid = (int)L; { const int q = nwg / NXCD, r = nwg % NXCD, xcd = wgid % NXCD, off = wgid / NXCD; wgid = (xcd < r ? xcd * (q + 1) : r * (q + 1) + (xcd - r) * q) + off; }
        const int nig = WGM * nN, gid = wgid / nig, fm = gid * WGM, gsz = (nM - fm) < WGM ? (nM - fm) : WGM;
        u.pm = fm + ((wgid % nig) % gsz); u.pn = (wgid % nig) / gsz; return true;
    }
    __device__ __forceinline__ void a_ready(const Unit&) const {}
    __device__ __forceinline__ void done(const Unit&) const {}
};

__device__ __forceinline__ unsigned cvt_pk_bf16(float lo, float hi) { unsigned r; asm volatile("v_cvt_pk_bf16_f32 %0, %1, %2" : "=v"(r) : "v"(lo), "v"(hi)); return r; }
typedef float f32x2 __attribute__((ext_vector_type(2)));

typedef unsigned u32x4_t __attribute__((ext_vector_type(4)));
constexpr float RMS_EPS = 1e-6f;
constexpr float LOG2E = 1.4426950408889634f;
constexpr float QSCALE = 0.125f * LOG2E;
constexpr int DM = 1024, DFF = 2816, DIN = 3072;

__device__ __forceinline__ float row_rstd(const float* ss, int row) {
    const f32x4* p = (const f32x4*)(ss + (size_t)row * 16);
    const f32x4 a = p[0], b = p[1], c = p[2], d = p[3];
    const float s = ((a[0] + a[1]) + (a[2] + a[3])) + ((b[0] + b[1]) + (b[2] + b[3])) + ((c[0] + c[1]) + (c[2] + c[3])) + ((d[0] + d[1]) + (d[2] + d[3]));
    return __builtin_amdgcn_rsqf(s * (1.0f / DM) + RMS_EPS);
}
__device__ __forceinline__ void rows_rstd(const float* ss, int row0, int fq, float (&rs)[2][4]) {
    f32x4 q[2][4];
#pragma unroll
    for (int ai = 0; ai < 2; ++ai)
#pragma unroll
        for (int m = 0; m < 4; ++m) q[ai][m] = *(const f32x4*)(ss + (size_t)(row0 + ai * HALF + m * 16) * 16 + 4 * fq);
#pragma unroll
    for (int ai = 0; ai < 2; ++ai)
#pragma unroll
        for (int m = 0; m < 4; ++m) { float t = (q[ai][m][0] + q[ai][m][1]) + (q[ai][m][2] + q[ai][m][3]); t += __shfl_xor(t, 16); t += __shfl_xor(t, 32); rs[ai][m] = __builtin_amdgcn_rsqf(t * (1.0f / DM) + RMS_EPS); }
}
__device__ __forceinline__ float sigmoidf_fast(float a) { return __builtin_amdgcn_rcpf(1.0f + __builtin_amdgcn_exp2f(-a * LOG2E)); }
__device__ __forceinline__ u32x4_t pack8(const f32x4 v0, const f32x4 v1) {
    u32x4_t w; w.x = cvt_pk_bf16(v0[0], v0[1]); w.y = cvt_pk_bf16(v0[2], v0[3]); w.z = cvt_pk_bf16(v1[0], v1[1]); w.w = cvt_pk_bf16(v1[2], v1[3]); return w;
}
__device__ __forceinline__ float bf_lo(unsigned w) { return __uint_as_float(w << 16); }
__device__ __forceinline__ float bf_hi(unsigned w) { return __uint_as_float(w & 0xffff0000u); }

struct EpiSwiglu {
    static constexpr bool PERM = true, AFTER_DRAIN = false;
    bf16_t* H; const float* ss;
    __device__ __forceinline__ void operator()(const f32x4 (&acc)[2][2][4][2], const Unit& u, int wr, int wc, int fr, int fq) const {
        const int hcol = u.pn * 128 + wc * 32 + 8 * fq;
        float rsv[2][4]; rows_rstd(ss, u.pm * BM + wr * 64 + fr, fq, rsv);
#pragma unroll
        for (int ai = 0; ai < 2; ++ai)
#pragma unroll
            for (int m = 0; m < 4; ++m) {
                const int row = u.pm * BM + ai * HALF + wr * 64 + m * 16 + fr;
                const float rs = rsv[ai][m];
                const float k1 = -rs * LOG2E, k2 = rs * rs;
                f32x4 o[2];
#pragma unroll
                for (int n = 0; n < 2; ++n) {
                    const f32x4 g4 = acc[ai][0][m][n], u4 = acc[ai][1][m][n];
#pragma unroll
                    for (int h = 0; h < 2; ++h) {
                        const f32x2 g = (f32x2){g4[2 * h], g4[2 * h + 1]}, up = (f32x2){u4[2 * h], u4[2 * h + 1]};
                        const f32x2 t = g * k1;
                        f32x2 e; e.x = __builtin_amdgcn_exp2f(t.x); e.y = __builtin_amdgcn_exp2f(t.y);
                        const f32x2 d = e + 1.0f;
                        f32x2 r; r.x = __builtin_amdgcn_rcpf(d.x); r.y = __builtin_amdgcn_rcpf(d.y);
                        const f32x2 v = (g * up) * (r * k2);
                        o[n][2 * h] = v.x; o[n][2 * h + 1] = v.y;
                    }
                }
                *(u32x4_t*)(H + (size_t)row * DFF + hcol) = pack8(o[0], o[1]);
            }
    }
};

struct EpiResid {
    static constexpr bool PERM = true, AFTER_DRAIN = false;
    const float* xin; float* xout; bf16_t* xb; float* ssw; float coef;
    __device__ __forceinline__ void operator()(const f32x4 (&acc)[2][2][4][2], const Unit& u, int wr, int wc, int fr, int fq) const {
        const size_t colb = (size_t)u.pn * BM + wc * 32 + 8 * fq;
        const int rowb = u.pm * BM + wr * 64 + fr;
        f32x4 a[2][2][2][2];
#define RES_LOAD(buf, b) do { _Pragma("unroll") for (int mm_ = 0; mm_ < 2; ++mm_) _Pragma("unroll") for (int bj_ = 0; bj_ < 2; ++bj_) { \
            const size_t off_ = (size_t)(rowb + ((b) >> 1) * HALF + (2 * ((b) & 1) + mm_) * 16) * DM + colb + bj_ * HALF; \
            a[buf][mm_][bj_][0] = *(const f32x4*)(xin + off_); a[buf][mm_][bj_][1] = *(const f32x4*)(xin + off_ + 4); } } while (0)
#define RES_STORE(buf, b) do { _Pragma("unroll") for (int mm_ = 0; mm_ < 2; ++mm_) { const int ai_ = (b) >> 1, m_ = 2 * ((b) & 1) + mm_; const int row_ = rowb + ai_ * HALF + m_ * 16; float sq_ = 0.f; \
            _Pragma("unroll") for (int bj_ = 0; bj_ < 2; ++bj_) { const size_t off_ = (size_t)row_ * DM + colb + bj_ * HALF; \
                const f32x4 v0_ = a[buf][mm_][bj_][0] + acc[ai_][bj_][m_][0] * coef, v1_ = a[buf][mm_][bj_][1] + acc[ai_][bj_][m_][1] * coef; \
                *(f32x4*)(xout + off_) = v0_; *(f32x4*)(xout + off_ + 4) = v1_; *(u32x4_t*)(xb + off_) = pack8(v0_, v1_); \
                sq_ += (v0_[0] * v0_[0] + v0_[1] * v0_[1]) + (v0_[2] * v0_[2] + v0_[3] * v0_[3]) + (v1_[0] * v1_[0] + v1_[1] * v1_[1]) + (v1_[2] * v1_[2] + v1_[3] * v1_[3]); } \
            sq_ += __shfl_xor(sq_, 16); sq_ += __shfl_xor(sq_, 32); if (fq == 0) ssw[(size_t)row_ * 16 + u.pn * 4 + wc] = sq_; } } while (0)
#define RES_FENCE() asm volatile("" ::: "memory")
        RES_LOAD(0, 0); RES_LOAD(1, 1); RES_FENCE();
        RES_STORE(0, 0); RES_FENCE(); RES_LOAD(0, 2); RES_FENCE();
        RES_STORE(1, 1); RES_FENCE(); RES_LOAD(1, 3); RES_FENCE();
        RES_STORE(0, 2); RES_FENCE();
        RES_STORE(1, 3);
#undef RES_LOAD
#undef RES_STORE
#undef RES_FENCE
    }
};

struct EpiWin {
    static constexpr bool PERM = true, AFTER_DRAIN = false;
    bf16_t* Z; const float* ss; const float* qg; const float* kg;
    __device__ __forceinline__ void operator()(const f32x4 (&acc)[2][2][4][2], const Unit& u, int wr, int wc, int fr, int fq) const {
        const bool isqk = u.pn < 4; const bool isq = u.pn < 2;
        float rsv[2][4]; rows_rstd(ss, u.pm * BM + wr * 64 + fr, fq, rsv);
        f32x4 gn[2][2];
#pragma unroll
        for (int bj = 0; bj < 2; ++bj)
#pragma unroll
            for (int n = 0; n < 2; ++n) {
                if (isqk) { const float* gp = (isq ? qg : kg) + 32 * bj + 8 * fq + 4 * n; gn[bj][n] = *(const f32x4*)gp; if (isq) gn[bj][n] = gn[bj][n] * QSCALE; }
                else gn[bj][n] = (f32x4){1.f, 1.f, 1.f, 1.f};
            }
#pragma unroll
        for (int ai = 0; ai < 2; ++ai)
#pragma unroll
            for (int m = 0; m < 4; ++m) {
                const int row = u.pm * BM + ai * HALF + wr * 64 + m * 16 + fr;
                const float rs = rsv[ai][m];
                f32x4 v[2][2]; float sq = 0.f;
#pragma unroll
                for (int bj = 0; bj < 2; ++bj)
#pragma unroll
                    for (int n = 0; n < 2; ++n) { v[bj][n] = acc[ai][bj][m][n] * rs; const f32x4 t = v[bj][n]; sq += (t[0] * t[0] + t[1] * t[1]) + (t[2] * t[2] + t[3] * t[3]); }
                float rn = 1.f;
                if (isqk) { sq += __shfl_xor(sq, 16); sq += __shfl_xor(sq, 32); rn = __builtin_amdgcn_rsqf(sq * (1.0f / 64.0f) + RMS_EPS); }
#pragma unroll
                for (int bj = 0; bj < 2; ++bj) {
                    const f32x4 o0 = v[bj][0] * rn * gn[bj][0], o1 = v[bj][1] * rn * gn[bj][1];
                    *(u32x4_t*)(Z + (size_t)row * DIN + u.pn * BM + 64 * wc + 32 * bj + 8 * fq) = pack8(o0, o1);
                }
            }
    }
};

struct EpiPlain {
    static constexpr bool PERM = true, AFTER_DRAIN = false;
    bf16_t* O;
    __device__ __forceinline__ void operator()(const f32x4 (&acc)[2][2][4][2], const Unit& u, int wr, int wc, int fr, int fq) const {
#pragma unroll
        for (int ai = 0; ai < 2; ++ai)
#pragma unroll
            for (int m = 0; m < 4; ++m) {
                const int row = u.pm * BM + ai * HALF + wr * 64 + m * 16 + fr;
#pragma unroll
                for (int bj = 0; bj < 2; ++bj)
                    *(u32x4_t*)(O + (size_t)row * DM + u.pn * BM + bj * HALF + wc * 32 + 8 * fq) = pack8(acc[ai][bj][m][0], acc[ai][bj][m][1]);
            }
    }
};

struct EpiPle {
    static constexpr bool PERM = true, AFTER_DRAIN = false;
    float* x; bf16_t* xb; const float* ssr; float* ssw; const bf16_t* pp; float coef; bool aux;
    __device__ __forceinline__ void operator()(const f32x4 (&acc)[2][2][4][2], const Unit& u, int wr, int wc, int fr, int fq) const {
        float rsv[2][4]; rows_rstd(ssr, u.pm * BM + wr * 64 + fr, fq, rsv);
        const size_t colb = (size_t)u.pn * BM + wc * 32 + 8 * fq;
#pragma unroll
        for (int ai = 0; ai < 2; ++ai)
#pragma unroll
            for (int m = 0; m < 4; ++m) {
                const int row = u.pm * BM + ai * HALF + wr * 64 + m * 16 + fr;
                const size_t off0 = (size_t)row * DM + colb;
                f32x4 a[2][2]; u32x4_t pw[2];
#pragma unroll
                for (int bj = 0; bj < 2; ++bj) { a[bj][0] = *(const f32x4*)(x + off0 + bj * HALF); a[bj][1] = *(const f32x4*)(x + off0 + bj * HALF + 4); pw[bj] = *(const u32x4_t*)(pp + off0 + bj * HALF); }
                asm volatile("" ::: "memory");
                const float rs = rsv[ai][m];
                float sq = 0.f;
#pragma unroll
                for (int bj = 0; bj < 2; ++bj) {
                    const size_t off = off0 + bj * HALF;
                    const u32x4_t w = pw[bj];
                    const f32x4 p0 = (f32x4){bf_lo(w.x), bf_hi(w.x), bf_lo(w.y), bf_hi(w.y)}, p1 = (f32x4){bf_lo(w.z), bf_hi(w.z), bf_lo(w.w), bf_hi(w.w)};
                    f32x4 v0, v1;
#pragma unroll
                    for (int j = 0; j < 4; ++j) { v0[j] = a[bj][0][j] + coef * sigmoidf_fast(acc[ai][bj][m][0][j] * rs) * p0[j]; v1[j] = a[bj][1][j] + coef * sigmoidf_fast(acc[ai][bj][m][1][j] * rs) * p1[j]; }
                    *(f32x4*)(x + off) = v0; *(f32x4*)(x + off + 4) = v1;
                    if (aux) *(u32x4_t*)(xb + off) = pack8(v0, v1);
                    sq += (v0[0] * v0[0] + v0[1] * v0[1]) + (v0[2] * v0[2] + v0[3] * v0[3]) + (v1[0] * v1[0] + v1[1] * v1[1]) + (v1[2] * v1[2] + v1[3] * v1[3]);
                }
                sq += __shfl_xor(sq, 16); sq += __shfl_xor(sq, 32);
                if (aux && fq == 0) ssw[(size_t)row * 16 + u.pn * 4 + wc] = sq;
                asm volatile("" ::: "memory");
            }
    }
};
template <class Epi, class Sched, bool ALIGN_EPI = false, bool SP2 = false>
__device__ __forceinline__ void gemm_phase(PG8_LAS unsigned char* lds, const Gemm g, const Sched& S, const Epi& E) {
    int tid_ = threadIdx.x; asm volatile("" : "+v"(tid_));
    const int tid = tid_, wid = __builtin_amdgcn_readfirstlane(tid >> 6), lane = tid & 63, wr = wid >> 2, wc = wid & 3, fr = lane & 15, fq = lane >> 4;
    const int K = g.K, nt = K / BK;
    unsigned voffA[2], voffB[2];
#pragma unroll
    for (int i = 0; i < 2; ++i) { int R, C; stage_rc(tid * 16 + i * 8192, R, C); const int Rb = Epi::PERM ? ((R & ~31) + perm32(R & 31)) : R;
        voffA[i] = (unsigned)(R * K + C) * 2u; voffB[i] = (unsigned)(Rb * K + C) * 2u; }
    const size_t kstep = (size_t)(BK * 2);
    const size_t hstep = (size_t)HALF * K * 2;
    const size_t tstep = 2 * hstep;
    const unsigned ldsw = (unsigned)wid * 1024u;
    const int aoff = lds_byte(wr * 64 + fr, fq * 8), boff = lds_byte(wc * 32 + fr, fq * 8);
#define PG8_SA(b, h) (((b) * 2 + (h)) * HTB)
#define PG8_SB(b, h) ((4 + (b) * 2 + (h)) * HTB)
#define PG8_STAGE(bufoff, gbase, voff) do { _Pragma("unroll") for (int _i = 0; _i < 2; ++_i) \
        __builtin_amdgcn_global_load_lds((const unsigned*)((const char*)(gbase) + (voff)[_i]), (PG8_LAS unsigned*)(lds + (bufoff) + ldsw + _i * 8192), 16, 0, 0); } while (0)
#define PG8_LDA(dst, b, h) do { _Pragma("unroll") for (int m = 0; m < 4; ++m) _Pragma("unroll") for (int k = 0; k < 2; ++k) dst[m][k] = *(const PG8_LAS bf16x8*)(lds + PG8_SA(b, h) + aoff + m * 2048 + k * 1024); } while (0)
#define PG8_LDB(dst, b, h) do { _Pragma("unroll") for (int n = 0; n < 2; ++n) _Pragma("unroll") for (int k = 0; k < 2; ++k) dst[n][k] = *(const PG8_LAS bf16x8*)(lds + PG8_SB(b, h) + boff + n * 2048 + k * 1024); } while (0)
#define PG8_MMA(ai, bj, At, Bt) do { __builtin_amdgcn_s_setprio(1); _Pragma("unroll") for (int m = 0; m < 4; ++m) _Pragma("unroll") for (int n = 0; n < 2; ++n) _Pragma("unroll") for (int k = 0; k < 2; ++k) \
        acc[ai][bj][m][n] = __builtin_amdgcn_mfma_f32_16x16x32_bf16(Bt[n][k], At[m][k], acc[ai][bj][m][n], 0, 0, 0); __builtin_amdgcn_s_setprio(0); } while (0)
#define PG8_WAIT_V(n) asm volatile("s_waitcnt vmcnt(" #n ")" ::: "memory")
#define PG8_WAIT_L(n) asm volatile("s_waitcnt lgkmcnt(" #n ")" ::: "memory")
#define PG8_BAR __builtin_amdgcn_s_barrier()
#define PG8_SCHED __builtin_amdgcn_sched_barrier(0)
    Unit cur, nxt; int ui = 0;
    if (!S.next(0, cur)) return;
    f32x4 acc[2][2][4][2];
#pragma unroll
    for (int a = 0; a < 2; ++a)
#pragma unroll
        for (int b = 0; b < 2; ++b)
#pragma unroll
            for (int m = 0; m < 4; ++m)
#pragma unroll
                for (int n = 0; n < 2; ++n) acc[a][b][m][n] = (f32x4){0.f, 0.f, 0.f, 0.f};
    bf16x8 At[4][2], B0[2][2], B1[2][2];
    const char* cA = (const char*)g.A + (size_t)cur.pm * tstep; const char* cB = (const char*)g.Bt + (size_t)cur.pn * tstep;
    S.a_ready(cur);
    if constexpr (SP2) {
        PG8_STAGE(PG8_SB(0, 0), cB, voffB); PG8_STAGE(PG8_SB(0, 1), cB + hstep, voffB); PG8_STAGE(PG8_SA(0, 0), cA, voffA); PG8_STAGE(PG8_SA(0, 1), cA + hstep, voffA);
        if (wr == 1) PG8_BAR;
        PG8_WAIT_V(2); PG8_BAR;
        PG8_STAGE(PG8_SB(1, 0), cB + kstep, voffB); PG8_STAGE(PG8_SA(1, 0), cA + kstep, voffA); PG8_STAGE(PG8_SB(1, 1), cB + hstep + kstep, voffB);
        PG8_WAIT_V(6); PG8_BAR;
    } else {
        PG8_STAGE(PG8_SB(0, 0), cB, voffB); PG8_STAGE(PG8_SA(0, 0), cA, voffA); PG8_STAGE(PG8_SB(0, 1), cB + hstep, voffB); PG8_STAGE(PG8_SA(0, 1), cA + hstep, voffA);
        if (wr == 1) PG8_BAR;
        PG8_WAIT_V(4); PG8_BAR;
        PG8_STAGE(PG8_SB(1, 0), cB + kstep, voffB); PG8_STAGE(PG8_SA(1, 0), cA + kstep, voffA); PG8_STAGE(PG8_SB(1, 1), cB + hstep + kstep, voffB);
        PG8_WAIT_V(6); PG8_BAR;
    }
    for (;;) {
        const bool has_next = S.next(ui + 1, nxt);
        const char* nA = has_next ? (const char*)g.A + (size_t)nxt.pm * tstep : cA; const char* nB = has_next ? (const char*)g.Bt + (size_t)nxt.pn * tstep : cB;
        for (int t = 0; t < nt; t += 2) {
            const bool last = (t == nt - 2);
            const char* a1 = cA + (size_t)(t + 1) * kstep;
            const char* a2 = last ? nA : cA + (size_t)(t + 2) * kstep; const char* b2 = last ? nB : cB + (size_t)(t + 2) * kstep;
            const char* a3 = a2 + kstep; const char* b3 = b2 + kstep;
            if (last && has_next) S.a_ready(nxt);
            if constexpr (SP2) {
            PG8_LDB(B0, 0, 0); PG8_LDB(B1, 0, 1); PG8_SCHED; PG8_LDA(At, 0, 0); PG8_STAGE(PG8_SA(1, 1), a1 + hstep, voffA);
            PG8_WAIT_V(8); PG8_WAIT_L(0); PG8_BAR; PG8_MMA(0, 0, At, B0); PG8_MMA(0, 1, At, B1); PG8_BAR; PG8_SCHED;
            PG8_LDA(At, 0, 1); PG8_STAGE(PG8_SB(0, 0), b2, voffB); PG8_STAGE(PG8_SB(0, 1), b2 + hstep, voffB); PG8_STAGE(PG8_SA(0, 0), a2, voffA);
            PG8_WAIT_V(8); PG8_WAIT_L(0); PG8_BAR; PG8_MMA(1, 0, At, B0); PG8_MMA(1, 1, At, B1); PG8_BAR; PG8_SCHED;
            PG8_LDB(B0, 1, 0); PG8_LDB(B1, 1, 1); PG8_SCHED; PG8_LDA(At, 1, 0); PG8_STAGE(PG8_SA(0, 1), a2 + hstep, voffA);
            PG8_WAIT_V(8); PG8_WAIT_L(0); PG8_BAR; PG8_MMA(0, 0, At, B0); PG8_MMA(0, 1, At, B1); PG8_BAR; PG8_SCHED;
            PG8_LDA(At, 1, 1); PG8_STAGE(PG8_SB(1, 0), b3, voffB); PG8_STAGE(PG8_SB(1, 1), b3 + hstep, voffB); PG8_STAGE(PG8_SA(1, 0), a3, voffA);
            PG8_WAIT_V(8); PG8_WAIT_L(0); PG8_BAR; PG8_MMA(1, 0, At, B0); PG8_MMA(1, 1, At, B1); PG8_BAR; PG8_SCHED;
            } else {
            PG8_LDB(B0, 0, 0); PG8_SCHED; PG8_LDA(At, 0, 0); PG8_STAGE(PG8_SA(1, 1), a1 + hstep, voffA);
            PG8_WAIT_L(8); PG8_BAR; PG8_WAIT_L(0); PG8_MMA(0, 0, At, B0); PG8_BAR; PG8_SCHED;
            PG8_LDB(B1, 0, 1); PG8_STAGE(PG8_SB(0, 0), b2, voffB);
            PG8_BAR; PG8_WAIT_L(0); PG8_MMA(0, 1, At, B1); PG8_BAR;
            PG8_LDA(At, 0, 1); PG8_STAGE(PG8_SA(0, 0), a2, voffA);
            PG8_BAR; PG8_WAIT_L(0); PG8_MMA(1, 0, At, B0); PG8_BAR; PG8_SCHED;
            PG8_STAGE(PG8_SB(0, 1), b2 + hstep, voffB);
            PG8_WAIT_V(6); PG8_BAR; PG8_MMA(1, 1, At, B1); PG8_BAR;
            PG8_LDB(B0, 1, 0); PG8_SCHED; PG8_LDA(At, 1, 0); PG8_STAGE(PG8_SA(0, 1), a2 + hstep, voffA);
            PG8_WAIT_L(8); PG8_BAR; PG8_WAIT_L(0); PG8_MMA(0, 0, At, B0); PG8_BAR; PG8_SCHED;
            PG8_LDB(B1, 1, 1); PG8_STAGE(PG8_SB(1, 0), b3, voffB);
            PG8_BAR; PG8_WAIT_L(0); PG8_MMA(0, 1, At, B1); PG8_BAR;
            PG8_LDA(At, 1, 1); PG8_STAGE(PG8_SA(1, 0), a3, voffA);
            PG8_BAR; PG8_WAIT_L(0); PG8_MMA(1, 0, At, B0); PG8_BAR; PG8_SCHED;
            PG8_STAGE(PG8_SB(1, 1), b3 + hstep, voffB);
            PG8_WAIT_V(6); PG8_BAR; PG8_MMA(1, 1, At, B1); PG8_BAR;
            }
        }
        if constexpr (ALIGN_EPI) { if (wr == 0) PG8_BAR; }
        if constexpr (!Epi::AFTER_DRAIN) { E(acc, cur, wr, wc, fr, fq); S.done(cur); }
        if (!has_next) break;
#pragma unroll
        for (int a = 0; a < 2; ++a)
#pragma unroll
            for (int b = 0; b < 2; ++b)
#pragma unroll
                for (int m = 0; m < 4; ++m)
#pragma unroll
                    for (int n = 0; n < 2; ++n) acc[a][b][m][n] = (f32x4){0.f, 0.f, 0.f, 0.f};
        cur = nxt; cA = nA; cB = nB; ++ui;
        if constexpr (ALIGN_EPI) { if (wr == 1) PG8_BAR; }
    }
    PG8_WAIT_V(0);
    if constexpr (!ALIGN_EPI) { if (wr == 0) PG8_BAR; }
    PG8_BAR;
    if constexpr (Epi::AFTER_DRAIN) { E.fused(acc, cur, wr, wc, fr, fq, lds, wid, lane); S.done(cur); }
#undef PG8_SA
#undef PG8_SB
#undef PG8_STAGE
#undef PG8_LDA
#undef PG8_LDB
#undef PG8_MMA
#undef PG8_WAIT_V
#undef PG8_WAIT_L
#undef PG8_BAR
#undef PG8_SCHED
}
}

namespace att {
typedef unsigned short bf16_t;
typedef short bf16x8 __attribute__((ext_vector_type(8)));
typedef short s16x4 __attribute__((ext_vector_type(4)));
typedef short v4i16_t __attribute__((ext_vector_type(4)));
typedef float f32x16 __attribute__((ext_vector_type(16)));
typedef float f32x4 __attribute__((ext_vector_type(4)));
typedef unsigned u32x4 __attribute__((ext_vector_type(4)));
typedef unsigned u32x2 __attribute__((ext_vector_type(2)));
#define ALAS __attribute__((address_space(3)))
constexpr int SEQ = 16384, ZP = 3072, QROWS = 128, NQB = SEQ / QROWS, DMODEL = 1024;
constexpr int STAGE = 32768, XB_OFF = 65536;
constexpr float EPS = 1e-6f;

__device__ __forceinline__ int crow(int r, int hi) { return (r & 3) + 8 * (r >> 2) + 4 * hi; }
typedef float f32x2_t __attribute__((ext_vector_type(2))); typedef __bf16 bf16x2_t __attribute__((ext_vector_type(2)));
__device__ __forceinline__ unsigned cvtpk(float lo, float hi) { f32x2_t v = {lo, hi}; bf16x2_t b = __builtin_convertvector(v, bf16x2_t); return __builtin_bit_cast(unsigned, b); }
__device__ __forceinline__ void glds16(const void* gsrc, unsigned lds_dst) { unsigned keep;
    asm volatile("s_mov_b32 %0, m0\n\ts_mov_b32 m0, %2\n\ts_nop 0\n\tglobal_load_lds_dwordx4 %1, off\n\ts_mov_b32 m0, %0" : "=&s"(keep) : "v"(gsrc), "s"(lds_dst) : "memory"); }
#define ATT_WAIT_BAR(N) asm volatile("s_waitcnt vmcnt(" #N ") lgkmcnt(0)\n\ts_barrier" ::: "memory")
__device__ __forceinline__ s16x4 vtr(const ALAS unsigned char* p) { return __builtin_bit_cast(s16x4, __builtin_amdgcn_ds_read_tr16_b64_v4i16((ALAS v4i16_t*)p)); }

__device__ __forceinline__ void attn_unit(ALAS unsigned char* lds, const bf16_t* __restrict__ z, bf16_t* __restrict__ A2, int h, int qb,
                                          float negM, float lam, const float* __restrict__ ogain, float oscale) {
    int tid_ = threadIdx.x; asm volatile("" : "+v"(tid_));
    const int tid = tid_, lane = tid & 63, wid = __builtin_amdgcn_readfirstlane(tid >> 6), r32 = lane & 31, hi = lane >> 5;
    const int m = wid & 1, g = wid >> 1;
    const int q0 = qb * QROWS, qrow = q0 + 32 * g + r32;
    bf16x8 qf[4];
    { const bf16_t* qp = z + (size_t)qrow * ZP + h * 128 + m * 64 + hi * 8;
#pragma unroll
      for (int d0 = 0; d0 < 4; ++d0) qf[d0] = *(const bf16x8*)(qp + 16 * d0); }
    const int NT = 2 * qb + 2;
    const int tlast = (q0 + 32 * g + 31) >> 6;
    const unsigned lds0 = (unsigned)(uintptr_t)lds;
    const int kkey0 = 16 * (wid & 3) + (lane >> 3);
    const bf16_t* ksrc = z + (size_t)kkey0 * ZP + 512 + h * 128 + (wid >> 2) * 64 + (((lane & 7) ^ ((kkey0 >> 1) & 7)) * 8);
    const bf16_t* ksrc2 = z + (size_t)(kkey0 + 8) * ZP + 512 + h * 128 + (wid >> 2) * 64 + (((lane & 7) ^ (((kkey0 + 8) >> 1) & 7)) * 8);
    const bf16_t* vsrc = z + (size_t)(16 * (wid & 3) + (lane >> 2)) * ZP + 1024 + h * 128 + (2 * (wid >> 2)) * 32 + (lane & 3) * 8;
    const unsigned kdst = lds0 + (wid >> 2) * 8192 + (2 * (wid & 3)) * 1024, vdst = lds0 + 65536 + (2 * (wid >> 2)) * 4096 + (wid & 3) * 1024;
#define ATT_DMAK(t) do { const size_t o_ = (size_t)(t) * 64 * ZP; const unsigned sb_ = (unsigned)((((t) >> 1) & 1) * 32768 + ((t) & 1) * 16384); \
        glds16(ksrc + o_, (unsigned)__builtin_amdgcn_readfirstlane(kdst + sb_)); glds16(ksrc2 + o_, (unsigned)__builtin_amdgcn_readfirstlane(kdst + sb_ + 1024)); } while (0)
#define ATT_DMAV(t) do { const size_t o_ = (size_t)(t) * 64 * ZP; const unsigned sb_ = (unsigned)(((t) & 3) * 16384); \
        glds16(vsrc + o_, (unsigned)__builtin_amdgcn_readfirstlane(vdst + sb_)); glds16(vsrc + o_ + 32, (unsigned)__builtin_amdgcn_readfirstlane(vdst + sb_ + 4096)); } while (0)
    asm volatile("" : "+v"(qf[0]), "+v"(qf[1]), "+v"(qf[2]), "+v"(qf[3]));
    asm volatile("s_waitcnt vmcnt(0)" ::: "memory");
    ATT_DMAK(0); ATT_DMAK(1); ATT_DMAV(0);
    ATT_WAIT_BAR(0);
    f32x16 o[4];
#pragma unroll
    for (int d = 0; d < 4; ++d)
#pragma unroll
        for (int r = 0; r < 16; ++r) o[d][r] = 0.f;
    float l = 0.f;
    const int kfx = (r32 >> 1) & 7;
    const int kro = m * 8192 + r32 * 128;
    const int kq0 = kro + ((0 + hi) ^ kfx) * 16, kq1 = kro + ((2 + hi) ^ kfx) * 16, kq2 = kro + ((4 + hi) ^ kfx) * 16, kq3 = kro + ((6 + hi) ^ kfx) * 16;
    const int vro = 65536 + ((lane >> 4) & 1) * 32 + (lane & 3) * 8 + (4 * hi + ((lane & 15) >> 2)) * 64;
    const f32x16 zero16 = {0.f, 0.f, 0.f, 0.f, 0.f, 0.f, 0.f, 0.f, 0.f, 0.f, 0.f, 0.f, 0.f, 0.f, 0.f, 0.f};
#define ATT_SBAR() __builtin_amdgcn_sched_barrier(0)
#define ATT_PIN(x) asm volatile("" : "+v"(x))
#define ATT_EX(v) __builtin_amdgcn_exp2f(v)
#define ATT_MF(a, b, c) __builtin_amdgcn_mfma_f32_32x32x16_bf16(a, b, c, 0, 0, 0)
#define ATT_VLOAD(arr, db) do { _Pragma("unroll") for (int ks_ = 0; ks_ < 4; ++ks_) { arr[2 * ks_] = vtr(Vb + (db) * 4096 + ks_ * 1024); arr[2 * ks_ + 1] = vtr(Vb + (db) * 4096 + ks_ * 1024 + 512); } } while (0)
#define ATT_VF(arr, ks) (bf16x8){arr[2 * (ks)][0], arr[2 * (ks)][1], arr[2 * (ks)][2], arr[2 * (ks)][3], arr[2 * (ks) + 1][0], arr[2 * (ks) + 1][1], arr[2 * (ks) + 1][2], arr[2 * (ks) + 1][3]}
#define ATT_PWB(PW, ks) __builtin_bit_cast(bf16x8, PW[ks])
#define ATT_QK(t) ATT_QKH(t, do { } while (0), do { } while (0))
#define ATT_QKH(t, HOOK, HOOK2) do { const ALAS unsigned char* Kb = lds + (((t) >> 1) & 1) * 32768 + ((t) & 1) * 16384; bf16x8 kf[4], kg2[4]; \
        kf[0] = *(const ALAS bf16x8*)(Kb + kq0); kf[1] = *(const ALAS bf16x8*)(Kb + kq0 + 4096); kf[2] = *(const ALAS bf16x8*)(Kb + kq1); kf[3] = *(const ALAS bf16x8*)(Kb + kq1 + 4096); \
        kg2[0] = *(const ALAS bf16x8*)(Kb + kq2); kg2[1] = *(const ALAS bf16x8*)(Kb + kq2 + 4096); kg2[2] = *(const ALAS bf16x8*)(Kb + kq3); kg2[3] = *(const ALAS bf16x8*)(Kb + kq3 + 4096); \
        ATT_SBAR(); HOOK; ATT_SBAR(); \
        c0 = ATT_MF(kf[0], qf[0], zero16); c1 = ATT_MF(kf[1], qf[0], zero16); c0 = ATT_MF(kf[2], qf[1], c0); c1 = ATT_MF(kf[3], qf[1], c1); \
        c0 = ATT_MF(kg2[0], qf[2], c0); c1 = ATT_MF(kg2[1], qf[2], c1); c0 = ATT_MF(kg2[2], qf[3], c0); c1 = ATT_MF(kg2[3], qf[3], c1); \
        ATT_SBAR(); HOOK2; ATT_SBAR(); } while (0)
#define ATT_SOFTMAX(PWN, t) do { \
        _Pragma("unroll") for (int r = 0; r < 16; ++r) { c0[r] = ATT_EX(c0[r]); c1[r] = ATT_EX(c1[r]); } \
        if ((t) == tlast) { const int kb_ = 64 * (t) + 4 * hi; \
            _Pragma("unroll") for (int r = 0; r < 16; ++r) { const int kk_ = kb_ + (r & 3) + 8 * (r >> 2); if (kk_ > qrow) c0[r] = 0.f; if (kk_ + 32 > qrow) c1[r] = 0.f; } } \
        float sa_ = 0.f, sb_ = 0.f; \
        _Pragma("unroll") for (int r = 0; r < 16; ++r) { sa_ += c0[r]; sb_ += c1[r]; } \
        l += sa_ + sb_; \
        _Pragma("unroll") for (int j = 0; j < 4; ++j) { \
            PWN[0][j] = cvtpk(c0[2 * j], c0[2 * j + 1]); PWN[1][j] = cvtpk(c0[8 + 2 * j], c0[8 + 2 * j + 1]); \
            PWN[2][j] = cvtpk(c1[2 * j], c1[2 * j + 1]); PWN[3][j] = cvtpk(c1[8 + 2 * j], c1[8 + 2 * j + 1]); } \
        ATT_SBAR(); } while (0)
#define ATT_PV(PWP, tt) do { const ALAS unsigned char* Vb = lds + ((tt) & 3) * 16384 + vro; s16x4 va[8], vb[8]; \
        ATT_VLOAD(va, 0); ATT_VLOAD(vb, 1); ATT_SBAR(); \
        _Pragma("unroll") for (int ks = 0; ks < 4; ++ks) o[0] = ATT_MF(ATT_VF(va, ks), ATT_PWB(PWP, ks), o[0]); \
        ATT_SBAR(); ATT_VLOAD(va, 2); ATT_SBAR(); \
        _Pragma("unroll") for (int ks = 0; ks < 4; ++ks) o[1] = ATT_MF(ATT_VF(vb, ks), ATT_PWB(PWP, ks), o[1]); \
        ATT_SBAR(); ATT_VLOAD(vb, 3); ATT_SBAR(); \
        _Pragma("unroll") for (int ks = 0; ks < 4; ++ks) o[2] = ATT_MF(ATT_VF(va, ks), ATT_PWB(PWP, ks), o[2]); \
        _Pragma("unroll") for (int ks = 0; ks < 4; ++ks) o[3] = ATT_MF(ATT_VF(vb, ks), ATT_PWB(PWP, ks), o[3]); \
        ATT_SBAR(); } while (0)
#define ATT_GAP(MFS, X, B, WORD) do { MFS; X[B] = ATT_EX(X[B]); X[(B) + 1] = ATT_EX(X[(B) + 1]); sacc += X[B]; sacc += X[(B) + 1]; WORD = cvtpk(X[B], X[(B) + 1]); ATT_PIN(sacc); ATT_SBAR(); } while (0)
#define ATT_PV_FUSED(PWP, PWN, t) do { const ALAS unsigned char* Vb = lds + (((t) - 1) & 3) * 16384 + vro; s16x4 va[8], vb[8]; float sacc = 0.f; \
        ATT_VLOAD(va, 0); ATT_VLOAD(vb, 1); ATT_SBAR(); \
        ATT_GAP(o[0] = ATT_MF(ATT_VF(va, 0), ATT_PWB(PWP, 0), o[0]), c0, 0, PWN[0][0]);  ATT_GAP(o[0] = ATT_MF(ATT_VF(va, 1), ATT_PWB(PWP, 1), o[0]), c0, 2, PWN[0][1]); \
        ATT_GAP(o[0] = ATT_MF(ATT_VF(va, 2), ATT_PWB(PWP, 2), o[0]), c0, 4, PWN[0][2]);  ATT_GAP(o[0] = ATT_MF(ATT_VF(va, 3), ATT_PWB(PWP, 3), o[0]), c0, 6, PWN[0][3]); \
        ATT_VLOAD(va, 2); ATT_SBAR(); \
        ATT_GAP(o[1] = ATT_MF(ATT_VF(vb, 0), ATT_PWB(PWP, 0), o[1]), c0, 8, PWN[1][0]);  ATT_GAP(o[1] = ATT_MF(ATT_VF(vb, 1), ATT_PWB(PWP, 1), o[1]), c0, 10, PWN[1][1]); \
        ATT_GAP(o[1] = ATT_MF(ATT_VF(vb, 2), ATT_PWB(PWP, 2), o[1]), c0, 12, PWN[1][2]); ATT_GAP(o[1] = ATT_MF(ATT_VF(vb, 3), ATT_PWB(PWP, 3), o[1]), c0, 14, PWN[1][3]); \
        ATT_VLOAD(vb, 3); ATT_SBAR(); \
        ATT_GAP(o[2] = ATT_MF(ATT_VF(va, 0), ATT_PWB(PWP, 0), o[2]), c1, 0, PWN[2][0]);  ATT_GAP(o[2] = ATT_MF(ATT_VF(va, 1), ATT_PWB(PWP, 1), o[2]), c1, 2, PWN[2][1]); \
        ATT_GAP(o[2] = ATT_MF(ATT_VF(va, 2), ATT_PWB(PWP, 2), o[2]), c1, 4, PWN[2][2]);  ATT_GAP(o[2] = ATT_MF(ATT_VF(va, 3), ATT_PWB(PWP, 3), o[2]), c1, 6, PWN[2][3]); \
        ATT_GAP(o[3] = ATT_MF(ATT_VF(vb, 0), ATT_PWB(PWP, 0), o[3]), c1, 8, PWN[3][0]);  ATT_GAP(o[3] = ATT_MF(ATT_VF(vb, 1), ATT_PWB(PWP, 1), o[3]), c1, 10, PWN[3][1]); \
        ATT_GAP(o[3] = ATT_MF(ATT_VF(vb, 2), ATT_PWB(PWP, 2), o[3]), c1, 12, PWN[3][2]); ATT_GAP(o[3] = ATT_MF(ATT_VF(vb, 3), ATT_PWB(PWP, 3), o[3]), c1, 14, PWN[3][3]); \
        l += sacc; } while (0)
#ifndef ATT_PROBE
#define ATT_PROBE 0
#endif
#if ATT_PROBE == 1
#define ATT_PROBE_CODE(t) do { const ALAS unsigned char* Kb = lds + ((t) & 3) * 32768 + kq0; bf16x8 kx = *(const ALAS bf16x8*)(Kb); f32x16 x0 = zero16, x1 = zero16; \
        _Pragma("unroll") for (int d0_ = 0; d0_ < 4; ++d0_) { x0 = ATT_MF(kx, qf[d0_], x0); x1 = ATT_MF(kx, qf[d0_], x1); } asm volatile("" :: "v"(x0), "v"(x1)); ATT_SBAR(); } while (0)
#elif ATT_PROBE == 2
#define ATT_PROBE_CODE(t) do { f32x16 x0 = c0, x1 = c1; _Pragma("unroll") for (int r = 0; r < 16; ++r) { x0[r] = ATT_EX(x0[r]); x1[r] = ATT_EX(x1[r]); } asm volatile("" :: "v"(x0), "v"(x1)); ATT_SBAR(); } while (0)
#elif ATT_PROBE == 3
#define ATT_PROBE_CODE(t) do { const ALAS unsigned char* Vb = lds + (((t) - 1) & 3) * 32768 + vro; const ALAS unsigned char* Kb = lds + ((t) & 3) * 32768 + kq0; s16x4 xa[8], xb_[8]; ATT_VLOAD(xa, 0); ATT_VLOAD(xb_, 1); \
        bf16x8 kx[8]; _Pragma("unroll") for (int i_ = 0; i_ < 8; ++i_) kx[i_] = *(const ALAS bf16x8*)(Kb + (i_ >> 1) * 2048 + (i_ & 1) * 512); \
        _Pragma("unroll") for (int i_ = 0; i_ < 8; ++i_) asm volatile("" :: "v"(xa[i_]), "v"(xb_[i_]), "v"(kx[i_])); ATT_SBAR(); } while (0)
#elif ATT_PROBE == 4
#define ATT_PROBE_CODE(t) do { asm volatile("s_waitcnt lgkmcnt(0)\n\ts_barrier" ::: "memory"); } while (0)
#else
#define ATT_PROBE_CODE(t) do { } while (0)
#endif
#define ATT_STEPX(PWP, PWN, t) do { \
        if ((t) < tlast) { ATT_QK(t); ATT_PROBE_CODE(t); ATT_PV_FUSED(PWP, PWN, t); } \
        else if ((t) == tlast) { ATT_QK(t); ATT_PV(PWP, (t) - 1); ATT_SOFTMAX(PWN, t); } \
        else if ((t) == tlast + 1) { ATT_PV(PWP, (t) - 1); } } while (0)
    f32x16 c0, c1;
    u32x4 pwa[4], pwb[4];
#pragma unroll
    for (int j = 0; j < 4; ++j) { pwa[j] = (u32x4){0u, 0u, 0u, 0u}; pwb[j] = (u32x4){0u, 0u, 0u, 0u}; }
    if (NT > 2) { ATT_DMAK(2); ATT_DMAK(3); }
    ATT_DMAV(1); if (NT > 2) { ATT_DMAV(2); }
    ATT_QK(0); ATT_SOFTMAX(pwa, 0);
    ATT_STEPX(pwa, pwb, 1);
    ATT_WAIT_BAR(0);
    int t = 2;
    for (; t + 5 <= NT; t += 2) {
        ATT_QKH(t, do { ATT_DMAK(t + 2); ATT_DMAK(t + 3); } while (0), do { ATT_DMAV(t + 1); ATT_DMAV(t + 2); } while (0)); ATT_PV_FUSED(pwb, pwa, t);
        ATT_QK(t + 1); ATT_PV_FUSED(pwa, pwb, t + 1);
        ATT_WAIT_BAR(0);
    }
    for (; t < NT; t += 2) {
        if (t + 2 < NT) { ATT_DMAK(t + 2); ATT_DMAK(t + 3); }
        ATT_DMAV(t + 1); if (t + 2 < NT) { ATT_DMAV(t + 2); }
        ATT_STEPX(pwb, pwa, t); ATT_STEPX(pwa, pwb, t + 1);
        ATT_WAIT_BAR(0);
    }
    if (tlast == NT - 1) { ATT_PV(pwb, NT - 1); }
    ATT_WAIT_BAR(0);
    l += __shfl_xor(l, 32);
    const float inv = 1.0f / l;
    ALAS float* xb = (ALAS float*)(lds + g * 16384);
    if (m == 1) {
        const float f = inv * lam;
#pragma unroll
        for (int db = 0; db < 4; ++db)
#pragma unroll
            for (int r = 0; r < 16; ++r) xb[(32 * db + crow(r, hi)) * 32 + r32] = o[db][r] * f;
    }
    __syncthreads();
    if (m == 0) {
        float ssq = 0.f;
#pragma unroll
        for (int db = 0; db < 4; ++db)
#pragma unroll
            for (int r = 0; r < 16; ++r) { const float v = o[db][r] * inv - xb[(32 * db + crow(r, hi)) * 32 + r32]; o[db][r] = v; ssq += v * v; }
        ssq += __shfl_xor(ssq, 32);
        const float rn = __builtin_amdgcn_rsqf(ssq * (1.0f / 128.0f) + EPS) * oscale;
        bf16_t* op = A2 + (size_t)qrow * DMODEL + h * 128;
#pragma unroll
        for (int db = 0; db < 4; ++db)
#pragma unroll
            for (int rq = 0; rq < 4; ++rq) {
                const int d = 32 * db + 8 * rq + 4 * hi;
                const f32x4 gv = *(const f32x4*)(ogain + d);
                u32x2 w; w.x = cvtpk(o[db][4 * rq] * rn * gv[0], o[db][4 * rq + 1] * rn * gv[1]); w.y = cvtpk(o[db][4 * rq + 2] * rn * gv[2], o[db][4 * rq + 3] * rn * gv[3]);
                *(u32x2*)(op + d) = w;
            }
    }
    __syncthreads();
}

__device__ __forceinline__ void unpack8(const u32x4 w, float (&f)[8]) {
    f[0] = __uint_as_float(w.x << 16); f[1] = __uint_as_float(w.x & 0xffff0000u); f[2] = __uint_as_float(w.y << 16); f[3] = __uint_as_float(w.y & 0xffff0000u);
    f[4] = __uint_as_float(w.z << 16); f[5] = __uint_as_float(w.z & 0xffff0000u); f[6] = __uint_as_float(w.w << 16); f[7] = __uint_as_float(w.w & 0xffff0000u);
}
__device__ __forceinline__ void conv_phase(const bf16_t* __restrict__ z, bf16_t* __restrict__ A2, const float* __restrict__ cw, const float* __restrict__ cb, const float* __restrict__ cgn,
                                           int gwave, int ngw, int lane) {
    const int c0 = lane * 8;
    float w0[8], w1[8], w2[8], bb[8], gg[8];
#pragma unroll
    for (int j = 0; j < 8; ++j) { w0[j] = cw[c0 + j]; w1[j] = cw[512 + c0 + j]; w2[j] = cw[1024 + c0 + j]; bb[j] = cb[c0 + j]; gg[j] = cgn[c0 + j]; }
    for (int task = gwave; task < SEQ / 8; task += ngw) {
        const int t0 = task * 8;
        float u1[8], u2[8];
#pragma unroll
        for (int j = 0; j < 8; ++j) { u1[j] = 0.f; u2[j] = 0.f; }
        if (t0 >= 2) {
            float a[8], b[8];
            unpack8(*(const u32x4*)(z + (size_t)(t0 - 2) * ZP + 2048 + c0), a); unpack8(*(const u32x4*)(z + (size_t)(t0 - 2) * ZP + 2560 + c0), b);
#pragma unroll
            for (int j = 0; j < 8; ++j) u2[j] = a[j] * b[j];
            unpack8(*(const u32x4*)(z + (size_t)(t0 - 1) * ZP + 2048 + c0), a); unpack8(*(const u32x4*)(z + (size_t)(t0 - 1) * ZP + 2560 + c0), b);
#pragma unroll
            for (int j = 0; j < 8; ++j) u1[j] = a[j] * b[j];
        }
        u32x4 GB[8], GC[8], HC[8];
#pragma unroll
        for (int tt = 0; tt < 8; ++tt) { const size_t ro = (size_t)(t0 + tt) * ZP; GB[tt] = *(const u32x4*)(z + ro + 1536 + c0); GC[tt] = *(const u32x4*)(z + ro + 2048 + c0); HC[tt] = *(const u32x4*)(z + ro + 2560 + c0); }
#pragma unroll
        for (int tt = 0; tt < 8; ++tt) {
            float gb[8], gc[8], hc[8], y[8];
            unpack8(GB[tt], gb); unpack8(GC[tt], gc); unpack8(HC[tt], hc);
            float ss = 0.f;
#pragma unroll
            for (int j = 0; j < 8; ++j) { const float u = gc[j] * hc[j]; y[j] = gb[j] * (w0[j] * u2[j] + w1[j] * u1[j] + w2[j] * u + bb[j]); ss += y[j] * y[j]; u2[j] = u1[j]; u1[j] = u; }
            ss += __shfl_xor(ss, 1); ss += __shfl_xor(ss, 2); ss += __shfl_xor(ss, 4);
            const float rn = __builtin_amdgcn_rsqf(ss * (1.0f / 64.0f) + EPS);
            u32x4 w;
            w.x = cvtpk(y[0] * rn * gg[0], y[1] * rn * gg[1]); w.y = cvtpk(y[2] * rn * gg[2], y[3] * rn * gg[3]);
            w.z = cvtpk(y[4] * rn * gg[4], y[5] * rn * gg[5]); w.w = cvtpk(y[6] * rn * gg[6], y[7] * rn * gg[7]);
            *(u32x4*)(A2 + (size_t)(t0 + tt) * DMODEL + 512 + c0) = w;
        }
    }
}
}

#define LAS __attribute__((address_space(3)))
typedef unsigned short bf16;
typedef unsigned v4u __attribute__((ext_vector_type(4)));
typedef float f32x4 __attribute__((ext_vector_type(4)));
constexpr int NWAVES = 8;
#ifndef PHMASK
#define PHMASK 0xFFFF
#endif
#ifndef RUNMASK
#define RUNMASK 0xFFFFu
#endif
constexpr int M = 16384, D = 1024, FF = 2816, NIN = 3072, DPLE = 256, DEPTH = 2;
constexpr int LDS_BYTES = 147456;
constexpr size_t LW = 45613056;
constexpr size_t OW_GU1 = 0, OW_D1 = 11534336, OW_IN = 17301504, OW_OUT = 23592960, OW_GU2 = 25690112, OW_D2 = 37224448, OW_PG = 42991616, OW_PP = 45088768;
constexpr size_t WS_PB = 2 * LW;
constexpr size_t WS_XB = WS_PB + 16777216;
constexpr size_t WS_SSA = WS_XB + 33554432, WS_SSB = WS_SSA + 1048576;
constexpr size_t WS_A2 = WS_SSB + 1048576;
constexpr size_t WS_Z = WS_A2 + 33554432;
constexpr size_t WS_END = WS_Z + 100663296;

__device__ __forceinline__ unsigned f2bf(float f) { unsigned u = __builtin_bit_cast(unsigned, f); return (u + 0x7fffu + ((u >> 16) & 1u)) >> 16; }
__device__ __forceinline__ unsigned pk2(float lo, float hi) { return f2bf(lo) | (f2bf(hi) << 16); }
__device__ __forceinline__ float wave_sum(float v) {
#pragma unroll
    for (int o = 1; o < 64; o <<= 1) v += __shfl_xor(v, o);
    return v;
}
__device__ __forceinline__ float wave_max(float v) {
#pragma unroll
    for (int o = 1; o < 64; o <<= 1) v = fmaxf(v, __shfl_xor(v, o));
    return v;
}
__device__ __forceinline__ void tr_item(const float* __restrict__ W, int K, int N, bf16* __restrict__ WT, int mode, const float* __restrict__ gain, LAS float* scr, int item, int lane) {
    const int nblk = N / 32, kb = item / nblk, nb = item % nblk, k0 = 64 * kb, n0 = 32 * nb;
    float wv[32];
#pragma unroll
    for (int i = 0; i < 32; ++i) { const int kk = 2 * i + (lane >> 5); wv[i] = __builtin_nontemporal_load(W + (size_t)(k0 + kk) * N + n0 + (lane & 31)); }
    if (gain) {
#pragma unroll
        for (int i = 0; i < 32; ++i) wv[i] *= gain[k0 + 2 * i + (lane >> 5)];
    }
#pragma unroll
    for (int i = 0; i < 32; ++i) scr[(2 * i + (lane >> 5)) * 33 + (lane & 31)] = wv[i];
    asm volatile("s_waitcnt lgkmcnt(0)" ::: "memory");
    int rb = n0;
    if (mode == 1) rb = 256 * (n0 >> 7) + (n0 & 127);
    else if (mode == 2) rb = 256 * (n0 >> 7) + 128 + (n0 & 127);
    else if (mode == 3) rb = (n0 & ~255) + 128 * ((n0 >> 5) & 1) + 32 * ((n0 >> 6) & 3);
    const int c = lane & 7;
#pragma unroll
    for (int j = 0; j < 4; ++j) { const int n = (lane >> 3) + 8 * j; const LAS float* s = scr + (8 * c) * 33 + n;
        v4u o; o.x = pk2(s[0 * 33], s[1 * 33]); o.y = pk2(s[2 * 33], s[3 * 33]); o.z = pk2(s[4 * 33], s[5 * 33]); o.w = pk2(s[6 * 33], s[7 * 33]);
        *(v4u*)(WT + (size_t)(rb + n) * K + k0 + 8 * c) = o; }
    asm volatile("s_waitcnt lgkmcnt(0)" ::: "memory");
}

#define XB_TMO      128
#define XB_XCNT(j)  (256  + 64 * (j))
#define XB_XSUB(j)  (1280 + 64 * (j))
#define XB_XGEN(j)  (2304 + 64 * (j))
#define XB_TOP      3328
#define XB_TOPGEN   3392
#define XCD_BAR_WORDS 3456
#define XB_SPIN_CAP (1u << 20)

__device__ __forceinline__ unsigned xb_ld(unsigned* p)              { return __hip_atomic_load(p, __ATOMIC_RELAXED, __HIP_MEMORY_SCOPE_AGENT); }
__device__ __forceinline__ unsigned xb_add(unsigned* p, unsigned v) { return __hip_atomic_fetch_add(p, v, __ATOMIC_RELAXED, __HIP_MEMORY_SCOPE_AGENT); }
__device__ __forceinline__ unsigned xb_xcc_id() { return (unsigned)__builtin_amdgcn_s_getreg((3 << 11) | 20) & 0xFu; }
#define XB_SPIN(cond, bar) do { unsigned _sp = 0; while (cond) { __builtin_amdgcn_s_sleep(1); \
    if ((++_sp & 255u) == 0u) { if (xb_ld(&(bar)[XB_TMO])) break; if (_sp > XB_SPIN_CAP) { atomicAdd(&(bar)[XB_TMO], 1u); break; } } } } while (0)

struct XcdBarrier {
    unsigned* bar; unsigned x;
    volatile LAS unsigned* st;
};

__device__ __forceinline__ XcdBarrier xcd_barrier_post(unsigned* bar, volatile LAS unsigned* st) {
    XcdBarrier b; b.bar = bar; b.x = xb_xcc_id(); b.st = st;
    if (threadIdx.x == 0) (void)xb_add(&bar[XB_XCNT(b.x)], 1u);
    return b;
}
__device__ __forceinline__ void xcd_barrier_complete(unsigned* bar, unsigned x, unsigned& nloc, unsigned& nx) {
    const unsigned G = gridDim.x * gridDim.y * gridDim.z;
    unsigned sum, cnt, mine, sp = 0u;
    for (;;) {
        sum = 0u; cnt = 0u; mine = 0u;
#pragma unroll
        for (unsigned j = 0; j < 16; ++j) { const unsigned c = xb_ld(&bar[XB_XCNT(j)]); sum += c; cnt += (c > 0u) ? 1u : 0u; mine = (j == x) ? c : mine; }
        if (sum == G) break;
        __builtin_amdgcn_s_sleep(1);
        if ((++sp & 255u) == 0u) { if (xb_ld(&bar[XB_TMO])) break; if (sp > XB_SPIN_CAP) { atomicAdd(&bar[XB_TMO], 1u); break; } }
    }
    nloc = mine > 0u ? mine : 1u; nx = cnt > 0u ? cnt : 1u;
}

__device__ __forceinline__ void xcd_barrier(const XcdBarrier& b) {
    asm volatile("s_waitcnt vmcnt(0)" ::: "memory");
    __syncthreads();
    if (threadIdx.x == 0) {
        unsigned* bar = b.bar;
        __builtin_amdgcn_s_waitcnt(0);
        unsigned nloc = b.st[0], nx = b.st[1];
        if (nloc == 0u) { xcd_barrier_complete(bar, b.x, nloc, nx); b.st[0] = nloc; b.st[1] = nx; }
        const unsigned old = xb_add(&bar[XB_XSUB(b.x)], 1u);
        const unsigned gen = old / nloc;
        if (old + 1u == (gen + 1u) * nloc) {
            __builtin_amdgcn_fence(__ATOMIC_RELEASE, "agent");
            asm volatile("s_waitcnt vmcnt(0)" ::: "memory");
            const unsigned og = xb_add(&bar[XB_TOP], 1u);
            const unsigned tg = og / nx;
            if (og + 1u == (tg + 1u) * nx) xb_add(&bar[XB_TOPGEN], 1u);
            else XB_SPIN(xb_ld(&bar[XB_TOPGEN]) == tg, bar);
            __builtin_amdgcn_fence(__ATOMIC_ACQUIRE, "agent");
            xb_add(&bar[XB_XGEN(b.x)], 1u);
            asm volatile("s_waitcnt vmcnt(0)" ::: "memory");
        } else {
            XB_SPIN(xb_ld(&bar[XB_XGEN(b.x)]) == gen, bar);
            __builtin_amdgcn_fence(__ATOMIC_ACQUIRE, "agent");
            asm volatile("s_waitcnt vmcnt(0)" ::: "memory");
        }
    }
    __syncthreads();
}

constexpr size_t WS_BAR = WS_END;
constexpr int MISC_OFF = 131072 + 512;
#define CONVERT_ITEMS(Lc, it0, it1, gwx, ngwx) do { \
        bf16* wlc = (bf16*)(ws + (size_t)(Lc) * LW); const size_t oF = (size_t)(Lc) * D * FF, oS = (size_t)(Lc) * D * D; \
        for (int it = (it0) + (gwx); it < (it1); it += (ngwx)) { \
            int r = it; \
            if (r < I_F) { tr_item(KA->in[3] + oF, D, FF, (bf16*)((unsigned char*)wlc + OW_GU1), 1, KA->in[2] + (Lc) * D, scr, r, lane); continue; } r -= I_F; \
            if (r < I_F) { tr_item(KA->in[4] + oF, D, FF, (bf16*)((unsigned char*)wlc + OW_GU1), 2, KA->in[2] + (Lc) * D, scr, r, lane); continue; } r -= I_F; \
            if (r < I_F) { tr_item(KA->in[5] + oF, FF, D, (bf16*)((unsigned char*)wlc + OW_D1), 0, nullptr, scr, r, lane); continue; } r -= I_F; \
            if (r < I_IN) { tr_item(KA->in[7] + (size_t)(Lc) * D * NIN, D, NIN, (bf16*)((unsigned char*)wlc + OW_IN), 3, KA->in[6] + (Lc) * D, scr, r, lane); continue; } r -= I_IN; \
            if (r < I_SQ) { tr_item(KA->in[18] + oS, D, D, (bf16*)((unsigned char*)wlc + OW_OUT), 0, nullptr, scr, r, lane); continue; } r -= I_SQ; \
            if (r < I_F) { tr_item(KA->in[20] + oF, D, FF, (bf16*)((unsigned char*)wlc + OW_GU2), 1, KA->in[19] + (Lc) * D, scr, r, lane); continue; } r -= I_F; \
            if (r < I_F) { tr_item(KA->in[21] + oF, D, FF, (bf16*)((unsigned char*)wlc + OW_GU2), 2, KA->in[19] + (Lc) * D, scr, r, lane); continue; } r -= I_F; \
            if (r < I_F) { tr_item(KA->in[22] + oF, FF, D, (bf16*)((unsigned char*)wlc + OW_D2), 0, nullptr, scr, r, lane); continue; } r -= I_F; \
            if (r < I_SQ) { tr_item(KA->in[24] + oS, D, D, (bf16*)((unsigned char*)wlc + OW_PG), 0, KA->in[23] + (Lc) * D, scr, r, lane); continue; } r -= I_SQ; \
            tr_item(KA->in[25] + (size_t)(Lc) * DPLE * D, DPLE, D, (bf16*)((unsigned char*)wlc + OW_PP), 0, nullptr, scr, r, lane); \
        } } while (0)
constexpr int I_F = 1408, I_IN = 1536, I_SQ = 512, I_PP = 128;
constexpr int ITEMS = 6 * I_F + I_IN + 2 * I_SQ + I_PP;
constexpr int ITEMS_GU1 = 2 * I_F;
constexpr int ITEMS_SPLIT = 7424;
struct Args { const float* in[26]; float* out; unsigned char* ws; unsigned mask; unsigned pad; };
typedef const __attribute__((address_space(4))) Args* KP;
#define KARGS() ((KP)__builtin_amdgcn_kernarg_segment_ptr())
#define PH_BEGIN KP KA = KARGS(); int Ll = L, Gl = G, bxl = bx, tidl = threadIdx.x; asm volatile("" : "+s"(KA), "+s"(Ll), "+s"(Gl), "+s"(bxl), "+v"(tidl)); unsigned char* ws = KA->ws; float* X = KA->out; \
    const int lane = tidl & 63, wave = __builtin_amdgcn_readfirstlane(tidl >> 6), vcu = (Gl % 8 == 0) ? (bxl % 8) * (Gl / 8) + bxl / 8 : bxl, gw = vcu * NWAVES + wave, NGW = Gl * NWAVES; (void)lane; (void)gw; (void)NGW; \
    const unsigned char* wl = ws + (size_t)Ll * LW; (void)wl; (void)Gl; (void)bxl; (void)X;
#define WPTR(off) ((const bf16*)(wl + (off)))
#define XB ((bf16*)(ws + WS_XB))
#define SSA ((float*)(ws + WS_SSA))
#define SSB ((float*)(ws + WS_SSB))
#define A2 ((bf16*)(ws + WS_A2))
#define Z ((bf16*)(ws + WS_Z))
#define PB ((bf16*)(ws + WS_PB))
#define Hb Z


__global__ void __launch_bounds__(NWAVES * 64, 2) fwd_mega(Args a) {
    extern __shared__ __attribute__((aligned(16))) unsigned char lds_raw[];
    LAS unsigned char* lds = (LAS unsigned char*)lds_raw;
    cg::grid_group grid = cg::this_grid();
    const int G = gridDim.x, bx = blockIdx.x;
    if (threadIdx.x < 2) ((volatile LAS unsigned*)(lds + MISC_OFF))[threadIdx.x] = 0u;
    if (threadIdx.x == 0) (void)xb_add((unsigned*)(KARGS()->ws + WS_BAR) + XB_XCNT(xb_xcc_id()), 1u);
#define GRID_BAR() do { XcdBarrier b_; b_.bar = (unsigned*)(KARGS()->ws + WS_BAR); b_.x = xb_xcc_id(); b_.st = (volatile LAS unsigned*)(lds + MISC_OFF); xcd_barrier(b_); } while (0)

#ifndef REP_P0
#define REP_P0 1
#endif
#ifndef REP_S1
#define REP_S1 1
#endif
#ifndef REP_S2
#define REP_S2 1
#endif
#ifndef REP_S3
#define REP_S3 1
#endif
#ifndef REP_S5
#define REP_S5 1
#endif
#ifndef REP_S8
#define REP_S8 1
#endif
    for (int rep = 0; rep < REP_P0; ++rep)
    if ((PHMASK & 1) && (KARGS()->mask & 1u)) {
        const int L = 0; PH_BEGIN (void)Ll;
        LAS float* scr = (LAS float*)(lds + wave * 16384);
        CONVERT_ITEMS(0, 0, ITEMS_GU1, gw, NGW);
        if (Gl != 256) { CONVERT_ITEMS(0, ITEMS_GU1, ITEMS, gw, NGW); CONVERT_ITEMS(1, 0, ITEMS, gw, NGW); }
        const float* xin = KA->in[0];
        for (int row = gw; row < M; row += NGW) {
            const f32x4* xr = (const f32x4*)(xin + (size_t)row * D) + lane;
            f32x4 v[4]; float s = 0.f;
#pragma unroll
            for (int j = 0; j < 4; ++j) { v[j] = xr[64 * j]; s += (v[j][0] * v[j][0] + v[j][1] * v[j][1]) + (v[j][2] * v[j][2] + v[j][3] * v[j][3]); }
            s = wave_sum(s);
            unsigned long long* o8 = (unsigned long long*)(XB + (size_t)row * D) + lane;
#pragma unroll
            for (int j = 0; j < 4; ++j) o8[64 * j] = (unsigned long long)pk2(v[j][0], v[j][1]) | ((unsigned long long)pk2(v[j][2], v[j][3]) << 32);
            if (lane < 16) SSB[(size_t)row * 16 + lane] = (lane == 0) ? s : 0.f;
        }
        const float* pin = KA->in[1];
        for (size_t i = (size_t)(bxl * (NWAVES * 64) + tidl) * 8; i < (size_t)DEPTH * M * DPLE; i += (size_t)Gl * NWAVES * 64 * 8) {
            const f32x4 v0 = *(const f32x4*)(pin + i), v1 = *(const f32x4*)(pin + i + 4);
            v4u o; o.x = pk2(v0[0], v0[1]); o.y = pk2(v0[2], v0[3]); o.z = pk2(v1[0], v1[1]); o.w = pk2(v1[2], v1[3]);
            *(v4u*)(PB + i) = o;
        }
    }
    GRID_BAR();
    if (KARGS()->mask == 0xC0FFEE11u) grid.sync();

#pragma unroll 1
    for (int L = 0; L < DEPTH; ++L) {
        for (int rep = 0; rep < REP_S1; ++rep)
        if ((PHMASK & 2) && (KARGS()->mask & 2u)) { PH_BEGIN pg8::Gemm g{XB, WPTR(OW_GU1), M, 2 * FF, D}; pg8::StaticOrder S; S.init(M, 2 * FF, Gl, bxl); pg8::EpiSwiglu E{Hb, SSB};
          pg8::gemm_phase<pg8::EpiSwiglu, pg8::StaticOrder, true, true>(lds, g, S, E);
          if (Gl == 256 && bxl >= 128) { LAS float* scr = (LAS float*)(lds + wave * 16384); CONVERT_ITEMS(Ll, ITEMS_GU1, ITEMS, (bxl - 128) * NWAVES + wave, 128 * NWAVES); } }
        GRID_BAR();
        for (int rep = 0; rep < REP_S2; ++rep)
        if ((PHMASK & 4) && (KARGS()->mask & 4u)) { PH_BEGIN pg8::Gemm g{Hb, WPTR(OW_D1), M, D, FF}; pg8::StaticOrder S; S.init(M, D, Gl, bxl); pg8::EpiResid E{(Ll == 0 && rep == 0) ? KA->in[0] : X, X, XB, SSA, rep == 0 ? 0.5f : 0.0f};
          pg8::gemm_phase<pg8::EpiResid, pg8::StaticOrder, true, true>(lds, g, S, E); }
        GRID_BAR();
        for (int rep = 0; rep < REP_S3; ++rep)
        if ((PHMASK & 8) && (KARGS()->mask & 8u)) { PH_BEGIN pg8::Gemm g{XB, WPTR(OW_IN), M, NIN, D}; pg8::StaticOrder S; S.init(M, NIN, Gl, bxl); pg8::EpiWin E{Z, SSA, KA->in[8] + Ll * 64, KA->in[9] + Ll * 64};
          pg8::gemm_phase<pg8::EpiWin, pg8::StaticOrder, true, true>(lds, g, S, E); }
        GRID_BAR();
        if ((PHMASK & 16) && (KARGS()->mask & 16u)) {
            PH_BEGIN
            att::conv_phase(Z, A2, KA->in[15] + Ll * 3 * 512, KA->in[16] + Ll * 512, KA->in[17] + Ll * 512, gw, NGW, lane);
            const float lam_init = (Ll == 0) ? 0.2f : (0.8f - 0.6f * 0.7408182206817179f);
            const float d1 = wave_sum(KA->in[10][Ll * 64 + lane] * KA->in[11][Ll * 64 + lane]);
            const float d2 = wave_sum(KA->in[12][Ll * 64 + lane] * KA->in[13][Ll * 64 + lane]);
            const float lam = __expf(d1) - __expf(d2) + lam_init;
            const float mq = wave_max(fabsf(KA->in[8][Ll * 64 + lane])), mk = wave_max(fabsf(KA->in[9][Ll * 64 + lane]));
            const float negM = -(64.0f * pg8::QSCALE * mq * mk);
#ifndef REP_ATT
#define REP_ATT 1
#endif
            for (int rep = 0; rep < REP_ATT; ++rep)
            for (int j = vcu; j < 256; j += Gl) {
                const int h = j >> 6, s = j & 63;
#pragma unroll 1
                for (int k2 = 0; k2 < 2; ++k2) att::attn_unit(lds, Z, A2, h, k2 == 0 ? 127 - s : s, negM, lam, KA->in[14] + Ll * 128, 1.0f - lam_init);
            }
        }
        GRID_BAR();
        for (int rep = 0; rep < REP_S5; ++rep)
        if ((PHMASK & 32) && (KARGS()->mask & 32u)) { PH_BEGIN pg8::Gemm g{A2, WPTR(OW_OUT), M, D, D}; pg8::StaticOrder S; S.init(M, D, Gl, bxl); pg8::EpiResid E{X, X, XB, SSB, rep == 0 ? 1.0f : 0.0f};
          pg8::gemm_phase<pg8::EpiResid, pg8::StaticOrder, true, true>(lds, g, S, E); }
        GRID_BAR();
        if ((PHMASK & 64) && (KARGS()->mask & 64u)) { PH_BEGIN pg8::Gemm g{XB, WPTR(OW_GU2), M, 2 * FF, D}; pg8::StaticOrder S; S.init(M, 2 * FF, Gl, bxl); pg8::EpiSwiglu E{Hb, SSB};
          pg8::gemm_phase<pg8::EpiSwiglu, pg8::StaticOrder, true, true>(lds, g, S, E); }
        if ((PHMASK & 128) && (KARGS()->mask & 128u)) { PH_BEGIN int Kp = DPLE; asm volatile("" : "+s"(Kp)); pg8::Gemm g{PB + (size_t)Ll * M * DPLE, WPTR(OW_PP), M, D, Kp}; pg8::StaticOrder S; const bool half_ = (Gl == 256); S.init(M, D, half_ ? 128 : Gl, half_ ? (bxl >= 128 ? bxl - 128 : 1 << 20) : bxl); pg8::EpiPlain E{A2};
          pg8::gemm_phase<pg8::EpiPlain, pg8::StaticOrder, true, true>(lds, g, S, E);
          if (Ll + 1 < DEPTH && Gl == 256 && bxl >= 128) { LAS float* scr = (LAS float*)(lds + wave * 16384); CONVERT_ITEMS(Ll + 1, 0, ITEMS_GU1, (bxl - 128) * NWAVES + wave, 128 * NWAVES); } }
        GRID_BAR();
        if ((PHMASK & 256) && (KARGS()->mask & 256u)) { PH_BEGIN pg8::Gemm g{Hb, WPTR(OW_D2), M, D, FF}; pg8::StaticOrder S; S.init(M, D, Gl, bxl); pg8::EpiResid E{X, X, XB, SSA, 0.5f};
          pg8::gemm_phase<pg8::EpiResid, pg8::StaticOrder, true, true>(lds, g, S, E); }
        GRID_BAR();
        for (int rep = 0; rep < REP_S8; ++rep)
        if ((PHMASK & 512) && (KARGS()->mask & 512u)) { PH_BEGIN pg8::Gemm g{XB, WPTR(OW_PG), M, D, D}; pg8::StaticOrder S; S.init(M, D, Gl, bxl); pg8::EpiPle E{X, XB, SSA, SSB, A2, rep == 0 ? 1.0f : 0.0f, Ll + 1 < DEPTH};
          pg8::gemm_phase<pg8::EpiPle, pg8::StaticOrder, true, true>(lds, g, S, E); }
        if (L + 1 < DEPTH) GRID_BAR();
    }
}

extern "C" void kernel_launch(void* const* d_in, const int* in_sizes, int n_in, void* d_out, int out_size, void* d_ws, size_t ws_size, hipStream_t stream) {
    static int grid = 0;
    if (grid == 0) {
        if (n_in != 26 || out_size != M * D || ws_size < WS_END + 16384) { fprintf(stderr, "kernel_launch: unexpected shapes (n_in %d, out %d, ws %zu < %zu)\n", n_in, out_size, ws_size, (size_t)WS_END); grid = -1; return; }
        int dev = 0, cus = 0, per_cu = 0;
        hipGetDevice(&dev);
        hipDeviceGetAttribute(&cus, hipDeviceAttributeMultiprocessorCount, dev);
        if (hipFuncSetAttribute((const void*)fwd_mega, hipFuncAttributeMaxDynamicSharedMemorySize, LDS_BYTES) != hipSuccess) { fprintf(stderr, "kernel_launch: hipFuncSetAttribute failed\n"); grid = -1; return; }
        if (hipOccupancyMaxActiveBlocksPerMultiprocessor(&per_cu, (const void*)fwd_mega, NWAVES * 64, LDS_BYTES) != hipSuccess || per_cu < 1) { fprintf(stderr, "kernel_launch: occupancy query gave %d\n", per_cu); per_cu = 1; }
        (void)hipGetLastError();
        grid = cus;
    }
    if (grid < 0) return;
    Args a{};
    for (int i = 0; i < 26; ++i) a.in[i] = (const float*)d_in[i];
    a.out = (float*)d_out; a.ws = (unsigned char*)d_ws; a.mask = RUNMASK; a.pad = 0;
    void* args[] = {&a};
    if (hipMemsetAsync((char*)d_ws + WS_BAR, 0, 16384, stream) != hipSuccess) { fprintf(stderr, "kernel_launch: hipMemsetAsync of the barrier words failed\n"); return; }
    hipError_t e = hipLaunchCooperativeKernel((const void*)fwd_mega, dim3(grid), dim3(NWAVES * 64), args, LDS_BYTES, stream);
    if (e != hipSuccess) fprintf(stderr, "kernel_launch: cooperative launch failed: %s (grid %d)\n", hipGetErrorString(e), grid);
}
```

```cpp
#include <hip/hip_runtime.h>
#include <hip/hip_cooperative_groups.h>
#include <cstdio>
#include <cstdint>
namespace cg = cooperative_groups;
namespace pg8 {
#define PG8_LAS __attribute__((address_space(3)))
typedef unsigned short bf16_t;
typedef short bf16x8 __attribute__((ext_vector_type(8)));
typedef float f32x4 __attribute__((ext_vector_type(4)));
typedef unsigned u32x4 __attribute__((ext_vector_type(4)));
constexpr int BM = 256, BK = 64, HALF = 128, HTB = HALF * BK * 2  , STAGE_BYTES = 8 * HTB, NXCD = 8, WGM = 8;

__host__ __device__ __forceinline__ int lds_byte(int r, int c) { const int st = (r >> 4) * 2 + (c >> 5), rr = r & 15, cc = c & 31, ob = rr * 64 + cc * 2; return st * 1024 + (ob ^ (((ob >> 9) & 1) << 5)); }
__host__ __device__ __forceinline__ void stage_rc(int b, int& R, int& C) { const int st = b / 1024, sb = b % 1024, swz = sb ^ (((sb >> 9) & 1) << 5); R = (st >> 1) * 16 + swz / 64; C = (st & 1) * 32 + (swz % 64) / 2; }
__host__ __device__ __forceinline__ int perm32(int rho) { const int n = rho >> 4, i = rho & 15; return 8 * (i >> 2) + 4 * n + (i & 3); }

struct Unit { int pm, pn; };
struct Gemm { const bf16_t* A; const bf16_t* Bt; int M, N, K; };

struct StaticOrder {
    int nM, nN, nwg, G, c;
    __host__ __device__ void init(int M, int N, int G_, int c_) { nM = M / BM; nN = N / BM; nwg = nM * nN; G = G_; c = c_; }
    __host__ __device__ bool next(int i, Unit& u) const {
        const long L = (long)i * G + c; if (L >= nwg) return false;
        int wgid = (int)L; { const int q = nwg / NXCD, r = nwg % NXCD, xcd = wgid % NXCD, off = wgid / NXCD; wgid = (xcd < r ? xcd * (q + 1) : r * (q + 1) + (xcd - r) * q) + off; }
        const int nig = WGM * nN, gid = wgid / nig, fm = gid * WGM, gsz = (nM - fm) < WGM ? (nM - fm) : WGM;
        u.pm = fm + ((wgid % nig) % gsz); u.pn = (wgid % nig) / gsz; return true;
    }
    __device__ __forceinline__ void a_ready(const Unit&) const {}
    __device__ __forceinline__ void done(const Unit&) const {}
};

__device__ __forceinline__ unsigned cvt_pk_bf16(float lo, float hi) { unsigned r; asm volatile("v_cvt_pk_bf16_f32 %0, %1, %2" : "=v"(r) : "v"(lo), "v"(hi)); return r; }
typedef float f32x2 __attribute__((ext_vector_type(2)));

typedef unsigned u32x4_t __attribute__((ext_vector_type(4)));
constexpr float RMS_EPS = 1e-6f;
constexpr float LOG2E = 1.4426950408889634f;
constexpr float QSCALE = 0.125f * LOG2E;
constexpr int DM = 1024, DFF = 2816, DIN = 3072;

__device__ __forceinline__ float row_rstd(const float* ss, int row) {
    const f32x4* p = (const f32x4*)(ss + (size_t)row * 16);
    const f32x4 a = p[0], b = p[1], c = p[2], d = p[3];
    const float s = ((a[0] + a[1]) + (a[2] + a[3])) + ((b[0] + b[1]) + (b[2] + b[3])) + ((c[0] + c[1]) + (c[2] + c[3])) + ((d[0] + d[1]) + (d[2] + d[3]));
    return __builtin_amdgcn_rsqf(s * (1.0f / DM) + RMS_EPS);
}
__device__ __forceinline__ void rows_rstd(const float* ss, int row0, int fq, float (&rs)[2][4]) {
    f32x4 q[2][4];
#pragma unroll
    for (int ai = 0; ai < 2; ++ai)
#pragma unroll
        for (int m = 0; m < 4; ++m) q[ai][m] = *(const f32x4*)(ss + (size_t)(row0 + ai * HALF + m * 16) * 16 + 4 * fq);
#pragma unroll
    for (int ai = 0; ai < 2; ++ai)
#pragma unroll
        for (int m = 0; m < 4; ++m) { float t = (q[ai][m][0] + q[ai][m][1]) + (q[ai][m][2] + q[ai][m][3]); t += __shfl_xor(t, 16); t += __shfl_xor(t, 32); rs[ai][m] = __builtin_amdgcn_rsqf(t * (1.0f / DM) + RMS_EPS); }
}
__device__ __forceinline__ float sigmoidf_fast(float a) { return __builtin_amdgcn_rcpf(1.0f + __builtin_amdgcn_exp2f(-a * LOG2E)); }
__device__ __forceinline__ u32x4_t pack8(const f32x4 v0, const f32x4 v1) {
    u32x4_t w; w.x = cvt_pk_bf16(v0[0], v0[1]); w.y = cvt_pk_bf16(v0[2], v0[3]); w.z = cvt_pk_bf16(v1[0], v1[1]); w.w = cvt_pk_bf16(v1[2], v1[3]); return w;
}
__device__ __forceinline__ float bf_lo(unsigned w) { return __uint_as_float(w << 16); }
__device__ __forceinline__ float bf_hi(unsigned w) { return __uint_as_float(w & 0xffff0000u); }

struct EpiSwiglu {
    static constexpr bool PERM = true, AFTER_DRAIN = false;
    bf16_t* H; const float* ss;
    __device__ __forceinline__ void operator()(const f32x4 (&acc)[2][2][4][2], const Unit& u, int wr, int wc, int fr, int fq) const {
        const int hcol = u.pn * 128 + wc * 32 + 8 * fq;
        float rsv[2][4]; rows_rstd(ss, u.pm * BM + wr * 64 + fr, fq, rsv);
#pragma unroll
        for (int ai = 0; ai < 2; ++ai)
#pragma unroll
            for (int m = 0; m < 4; ++m) {
                const int row = u.pm * BM + ai * HALF + wr * 64 + m * 16 + fr;
                const float rs = rsv[ai][m];
                const float k1 = -rs * LOG2E, k2 = rs * rs;
                f32x4 o[2];
#pragma unroll
                for (int n = 0; n < 2; ++n) {
                    const f32x4 g4 = acc[ai][0][m][n], u4 = acc[ai][1][m][n];
#pragma unroll
                    for (int h = 0; h < 2; ++h) {
                        const f32x2 g = (f32x2){g4[2 * h], g4[2 * h + 1]}, up = (f32x2){u4[2 * h], u4[2 * h + 1]};
                        const f32x2 t = g * k1;
                        f32x2 e; e.x = __builtin_amdgcn_exp2f(t.x); e.y = __builtin_amdgcn_exp2f(t.y);
                        const f32x2 d = e + 1.0f;
                        f32x2 r; r.x = __builtin_amdgcn_rcpf(d.x); r.y = __builtin_amdgcn_rcpf(d.y);
                        const f32x2 v = (g * up) * (r * k2);
                        o[n][2 * h] = v.x; o[n][2 * h + 1] = v.y;
                    }
                }
                *(u32x4_t*)(H + (size_t)row * DFF + hcol) = pack8(o[0], o[1]);
            }
    }
};

struct EpiResid {
    static constexpr bool PERM = true, AFTER_DRAIN = false;
    const float* xin; float* xout; bf16_t* xb; float* ssw; float coef;
    __device__ __forceinline__ void operator()(const f32x4 (&acc)[2][2][4][2], const Unit& u, int wr, int wc, int fr, int fq) const {
        const size_t colb = (size_t)u.pn * BM + wc * 32 + 8 * fq;
        const int rowb = u.pm * BM + wr * 64 + fr;
        f32x4 a[2][2][2][2];
#define RES_LOAD(buf, b) do { _Pragma("unroll") for (int mm_ = 0; mm_ < 2; ++mm_) _Pragma("unroll") for (int bj_ = 0; bj_ < 2; ++bj_) { \
            const size_t off_ = (size_t)(rowb + ((b) >> 1) * HALF + (2 * ((b) & 1) + mm_) * 16) * DM + colb + bj_ * HALF; \
            a[buf][mm_][bj_][0] = *(const f32x4*)(xin + off_); a[buf][mm_][bj_][1] = *(const f32x4*)(xin + off_ + 4); } } while (0)
#define RES_STORE(buf, b) do { _Pragma("unroll") for (int mm_ = 0; mm_ < 2; ++mm_) { const int ai_ = (b) >> 1, m_ = 2 * ((b) & 1) + mm_; const int row_ = rowb + ai_ * HALF + m_ * 16; float sq_ = 0.f; \
            _Pragma("unroll") for (int bj_ = 0; bj_ < 2; ++bj_) { const size_t off_ = (size_t)row_ * DM + colb + bj_ * HALF; \
                const f32x4 v0_ = a[buf][mm_][bj_][0] + acc[ai_][bj_][m_][0] * coef, v1_ = a[buf][mm_][bj_][1] + acc[ai_][bj_][m_][1] * coef; \
                *(f32x4*)(xout + off_) = v0_; *(f32x4*)(xout + off_ + 4) = v1_; *(u32x4_t*)(xb + off_) = pack8(v0_, v1_); \
                sq_ += (v0_[0] * v0_[0] + v0_[1] * v0_[1]) + (v0_[2] * v0_[2] + v0_[3] * v0_[3]) + (v1_[0] * v1_[0] + v1_[1] * v1_[1]) + (v1_[2] * v1_[2] + v1_[3] * v1_[3]); } \
            sq_ += __shfl_xor(sq_, 16); sq_ += __shfl_xor(sq_, 32); if (fq == 0) ssw[(size_t)row_ * 16 + u.pn * 4 + wc] = sq_; } } while (0)
#define RES_FENCE() asm volatile("" ::: "memory")
        RES_LOAD(0, 0); RES_LOAD(1, 1); RES_FENCE();
        RES_STORE(0, 0); RES_FENCE(); RES_LOAD(0, 2); RES_FENCE();
        RES_STORE(1, 1); RES_FENCE(); RES_LOAD(1, 3); RES_FENCE();
        RES_STORE(0, 2); RES_FENCE();
        RES_STORE(1, 3);
#undef RES_LOAD
#undef RES_STORE
#undef RES_FENCE
    }
};

struct EpiWin {
    static constexpr bool PERM = true, AFTER_DRAIN = false;
    bf16_t* Z; const float* ss; const float* qg; const float* kg;
    __device__ __forceinline__ void operator()(const f32x4 (&acc)[2][2][4][2], const Unit& u, int wr, int wc, int fr, int fq) const {
        const bool isqk = u.pn < 4; const bool isq = u.pn < 2;
        float rsv[2][4]; rows_rstd(ss, u.pm * BM + wr * 64 + fr, fq, rsv);
        f32x4 gn[2][2];
#pragma unroll
        for (int bj = 0; bj < 2; ++bj)
#pragma unroll
            for (int n = 0; n < 2; ++n) {
                if (isqk) { const float* gp = (isq ? qg : kg) + 32 * bj + 8 * fq + 4 * n; gn[bj][n] = *(const f32x4*)gp; if (isq) gn[bj][n] = gn[bj][n] * QSCALE; }
                else gn[bj][n] = (f32x4){1.f, 1.f, 1.f, 1.f};
            }
#pragma unroll
        for (int ai = 0; ai < 2; ++ai)
#pragma unroll
            for (int m = 0; m < 4; ++m) {
                const int row = u.pm * BM + ai * HALF + wr * 64 + m * 16 + fr;
                const float rs = rsv[ai][m];
                f32x4 v[2][2]; float sq = 0.f;
#pragma unroll
                for (int bj = 0; bj < 2; ++bj)
#pragma unroll
                    for (int n = 0; n < 2; ++n) { v[bj][n] = acc[ai][bj][m][n] * rs; const f32x4 t = v[bj][n]; sq += (t[0] * t[0] + t[1] * t[1]) + (t[2] * t[2] + t[3] * t[3]); }
                float rn = 1.f;
                if (isqk) { sq += __shfl_xor(sq, 16); sq += __shfl_xor(sq, 32); rn = __builtin_amdgcn_rsqf(sq * (1.0f / 64.0f) + RMS_EPS); }
#pragma unroll
                for (int bj = 0; bj < 2; ++bj) {
                    const f32x4 o0 = v[bj][0] * rn * gn[bj][0], o1 = v[bj][1] * rn * gn[bj][1];
                    *(u32x4_t*)(Z + (size_t)row * DIN + u.pn * BM + 64 * wc + 32 * bj + 8 * fq) = pack8(o0, o1);
                }
            }
    }
};

struct EpiPlain {
    static constexpr bool PERM = true, AFTER_DRAIN = false;
    bf16_t* O;
    __device__ __forceinline__ void operator()(const f32x4 (&acc)[2][2][4][2], const Unit& u, int wr, int wc, int fr, int fq) const {
#pragma unroll
        for (int ai = 0; ai < 2; ++ai)
#pragma unroll
            for (int m = 0; m < 4; ++m) {
                const int row = u.pm * BM + ai * HALF + wr * 64 + m * 16 + fr;
#pragma unroll
                for (int bj = 0; bj < 2; ++bj)
                    *(u32x4_t*)(O + (size_t)row * DM + u.pn * BM + bj * HALF + wc * 32 + 8 * fq) = pack8(acc[ai][bj][m][0], acc[ai][bj][m][1]);
            }
    }
};

struct EpiPle {
    static constexpr bool PERM = true, AFTER_DRAIN = false;
    float* x; bf16_t* xb; const float* ssr; float* ssw; const bf16_t* pp; float coef; bool aux;
    __device__ __forceinline__ void operator()(const f32x4 (&acc)[2][2][4][2], const Unit& u, int wr, int wc, int fr, int fq) const {
        float rsv[2][4]; rows_rstd(ssr, u.pm * BM + wr * 64 + fr, fq, rsv);
        const size_t colb = (size_t)u.pn * BM + wc * 32 + 8 * fq;
#pragma unroll
        for (int ai = 0; ai < 2; ++ai)
#pragma unroll
            for (int m = 0; m < 4; ++m) {
                const int row = u.pm * BM + ai * HALF + wr * 64 + m * 16 + fr;
                const size_t off0 = (size_t)row * DM + colb;
                f32x4 a[2][2]; u32x4_t pw[2];
#pragma unroll
                for (int bj = 0; bj < 2; ++bj) { a[bj][0] = *(const f32x4*)(x + off0 + bj * HALF); a[bj][1] = *(const f32x4*)(x + off0 + bj * HALF + 4); pw[bj] = *(const u32x4_t*)(pp + off0 + bj * HALF); }
                asm volatile("" ::: "memory");
                const float rs = rsv[ai][m];
                float sq = 0.f;
#pragma unroll
                for (int bj = 0; bj < 2; ++bj) {
                    const size_t off = off0 + bj * HALF;
                    const u32x4_t w = pw[bj];
                    const f32x4 p0 = (f32x4){bf_lo(w.x), bf_hi(w.x), bf_lo(w.y), bf_hi(w.y)}, p1 = (f32x4){bf_lo(w.z), bf_hi(w.z), bf_lo(w.w), bf_hi(w.w)};
                    f32x4 v0, v1;
#pragma unroll
                    for (int j = 0; j < 4; ++j) { v0[j] = a[bj][0][j] + coef * sigmoidf_fast(acc[ai][bj][m][0][j] * rs) * p0[j]; v1[j] = a[bj][1][j] + coef * sigmoidf_fast(acc[ai][bj][m][1][j] * rs) * p1[j]; }
                    *(f32x4*)(x + off) = v0; *(f32x4*)(x + off + 4) = v1;
                    if (aux) *(u32x4_t*)(xb + off) = pack8(v0, v1);
                    sq += (v0[0] * v0[0] + v0[1] * v0[1]) + (v0[2] * v0[2] + v0[3] * v0[3]) + (v1[0] * v1[0] + v1[1] * v1[1]) + (v1[2] * v1[2] + v1[3] * v1[3]);
                }
                sq += __shfl_xor(sq, 16); sq += __shfl_xor(sq, 32);
                if (aux && fq == 0) ssw[(size_t)row * 16 + u.pn * 4 + wc] = sq;
                asm volatile("" ::: "memory");
            }
    }
};
template <class Epi, class Sched, bool ALIGN_EPI = false, bool SP2 = false>
__device__ __forceinline__ void gemm_phase(PG8_LAS unsigned char* lds, const Gemm g, const Sched& S, const Epi& E) {
    int tid_ = threadIdx.x; asm volatile("" : "+v"(tid_));
    const int tid = tid_, wid = __builtin_amdgcn_readfirstlane(tid >> 6), lane = tid & 63, wr = wid >> 2, wc = wid & 3, fr = lane & 15, fq = lane >> 4;
    const int K = g.K, nt = K / BK;
    unsigned voffA[2], voffB[2];
#pragma unroll
    for (int i = 0; i < 2; ++i) { int R, C; stage_rc(tid * 16 + i * 8192, R, C); const int Rb = Epi::PERM ? ((R & ~31) + perm32(R & 31)) : R;
        voffA[i] = (unsigned)(R * K + C) * 2u; voffB[i] = (unsigned)(Rb * K + C) * 2u; }
    const size_t kstep = (size_t)(BK * 2);
    const size_t hstep = (size_t)HALF * K * 2;
    const size_t tstep = 2 * hstep;
    const unsigned ldsw = (unsigned)wid * 1024u;
    const int aoff = lds_byte(wr * 64 + fr, fq * 8), boff = lds_byte(wc * 32 + fr, fq * 8);
#define PG8_SA(b, h) (((b) * 2 + (h)) * HTB)
#define PG8_SB(b, h) ((4 + (b) * 2 + (h)) * HTB)
#define PG8_STAGE(bufoff, gbase, voff) do { _Pragma("unroll") for (int _i = 0; _i < 2; ++_i) \
        __builtin_amdgcn_global_load_lds((const unsigned*)((const char*)(gbase) + (voff)[_i]), (PG8_LAS unsigned*)(lds + (bufoff) + ldsw + _i * 8192), 16, 0, 0); } while (0)
#define PG8_LDA(dst, b, h) do { _Pragma("unroll") for (int m = 0; m < 4; ++m) _Pragma("unroll") for (int k = 0; k < 2; ++k) dst[m][k] = *(const PG8_LAS bf16x8*)(lds + PG8_SA(b, h) + aoff + m * 2048 + k * 1024); } while (0)
#define PG8_LDB(dst, b, h) do { _Pragma("unroll") for (int n = 0; n < 2; ++n) _Pragma("unroll") for (int k = 0; k < 2; ++k) dst[n][k] = *(const PG8_LAS bf16x8*)(lds + PG8_SB(b, h) + boff + n * 2048 + k * 1024); } while (0)
#define PG8_MMA(ai, bj, At, Bt) do { __builtin_amdgcn_s_setprio(1); _Pragma("unroll") for (int m = 0; m < 4; ++m) _Pragma("unroll") for (int n = 0; n < 2; ++n) _Pragma("unroll") for (int k = 0; k < 2; ++k) \
        acc[ai][bj][m][n] = __builtin_amdgcn_mfma_f32_16x16x32_bf16(Bt[n][k], At[m][k], acc[ai][bj][m][n], 0, 0, 0); __builtin_amdgcn_s_setprio(0); } while (0)
#define PG8_WAIT_V(n) asm volatile("s_waitcnt vmcnt(" #n ")" ::: "memory")
#define PG8_WAIT_L(n) asm volatile("s_waitcnt lgkmcnt(" #n ")" ::: "memory")
#define PG8_BAR __builtin_amdgcn_s_barrier()
#define PG8_SCHED __builtin_amdgcn_sched_barrier(0)
    Unit cur, nxt; int ui = 0;
    if (!S.next(0, cur)) return;
    f32x4 acc[2][2][4][2];
#pragma unroll
    for (int a = 0; a < 2; ++a)
#pragma unroll
        for (int b = 0; b < 2; ++b)
#pragma unroll
            for (int m = 0; m < 4; ++m)
#pragma unroll
                for (int n = 0; n < 2; ++n) acc[a][b][m][n] = (f32x4){0.f, 0.f, 0.f, 0.f};
    bf16x8 At[4][2], B0[2][2], B1[2][2];
    const char* cA = (const char*)g.A + (size_t)cur.pm * tstep; const char* cB = (const char*)g.Bt + (size_t)cur.pn * tstep;
    S.a_ready(cur);
    if constexpr (SP2) {
        PG8_STAGE(PG8_SB(0, 0), cB, voffB); PG8_STAGE(PG8_SB(0, 1), cB + hstep, voffB); PG8_STAGE(PG8_SA(0, 0), cA, voffA); PG8_STAGE(PG8_SA(0, 1), cA + hstep, voffA);
        if (wr == 1) PG8_BAR;
        PG8_WAIT_V(2); PG8_BAR;
        PG8_STAGE(PG8_SB(1, 0), cB + kstep, voffB); PG8_STAGE(PG8_SA(1, 0), cA + kstep, voffA); PG8_STAGE(PG8_SB(1, 1), cB + hstep + kstep, voffB);
        PG8_WAIT_V(6); PG8_BAR;
    } else {
        PG8_STAGE(PG8_SB(0, 0), cB, voffB); PG8_STAGE(PG8_SA(0, 0), cA, voffA); PG8_STAGE(PG8_SB(0, 1), cB + hstep, voffB); PG8_STAGE(PG8_SA(0, 1), cA + hstep, voffA);
        if (wr == 1) PG8_BAR;
        PG8_WAIT_V(4); PG8_BAR;
        PG8_STAGE(PG8_SB(1, 0), cB + kstep, voffB); PG8_STAGE(PG8_SA(1, 0), cA + kstep, voffA); PG8_STAGE(PG8_SB(1, 1), cB + hstep + kstep, voffB);
        PG8_WAIT_V(6); PG8_BAR;
    }
    for (;;) {
        const bool has_next = S.next(ui + 1, nxt);
        const char* nA = has_next ? (const char*)g.A + (size_t)nxt.pm * tstep : cA; const char* nB = has_next ? (const char*)g.Bt + (size_t)nxt.pn * tstep : cB;
        for (int t = 0; t < nt; t += 2) {
            const bool last = (t == nt - 2);
            const char* a1 = cA + (size_t)(t + 1) * kstep;
            const char* a2 = last ? nA : cA + (size_t)(t + 2) * kstep; const char* b2 = last ? nB : cB + (size_t)(t + 2) * kstep;
            const char* a3 = a2 + kstep; const char* b3 = b2 + kstep;
            if (last && has_next) S.a_ready(nxt);
            if constexpr (SP2) {
            PG8_LDB(B0, 0, 0); PG8_LDB(B1, 0, 1); PG8_SCHED; PG8_LDA(At, 0, 0); PG8_STAGE(PG8_SA(1, 1), a1 + hstep, voffA);
            PG8_WAIT_V(8); PG8_WAIT_L(0); PG8_BAR; PG8_MMA(0, 0, At, B0); PG8_MMA(0, 1, At, B1); PG8_BAR; PG8_SCHED;
            PG8_LDA(At, 0, 1); PG8_STAGE(PG8_SB(0, 0), b2, voffB); PG8_STAGE(PG8_SB(0, 1), b2 + hstep, voffB); PG8_STAGE(PG8_SA(0, 0), a2, voffA);
            PG8_WAIT_V(8); PG8_WAIT_L(0); PG8_BAR; PG8_MMA(1, 0, At, B0); PG8_MMA(1, 1, At, B1); PG8_BAR; PG8_SCHED;
            PG8_LDB(B0, 1, 0); PG8_LDB(B1, 1, 1); PG8_SCHED; PG8_LDA(At, 1, 0); PG8_STAGE(PG8_SA(0, 1), a2 + hstep, voffA);
            PG8_WAIT_V(8); PG8_WAIT_L(0); PG8_BAR; PG8_MMA(0, 0, At, B0); PG8_MMA(0, 1, At, B1); PG8_BAR; PG8_SCHED;
            PG8_LDA(At, 1, 1); PG8_STAGE(PG8_SB(1, 0), b3, voffB); PG8_STAGE(PG8_SB(1, 1), b3 + hstep, voffB); PG8_STAGE(PG8_SA(1, 0), a3, voffA);
            PG8_WAIT_V(8); PG8_WAIT_L(0); PG8_BAR; PG8_MMA(1, 0, At, B0); PG8_MMA(1, 1, At, B1); PG8_BAR; PG8_SCHED;
            } else {
            PG8_LDB(B0, 0, 0); PG8_SCHED; PG8_LDA(At, 0, 0); PG8_STAGE(PG8_SA(1, 1), a1 + hstep, voffA);
            PG8_WAIT_L(8); PG8_BAR; PG8_WAIT_L(0); PG8_MMA(0, 0, At, B0); PG8_BAR; PG8_SCHED;
            PG8_LDB(B1, 0, 1); PG8_STAGE(PG8_SB(0, 0), b2, voffB);
            PG8_BAR; PG8_WAIT_L(0); PG8_MMA(0, 1, At, B1); PG8_BAR;
            PG8_LDA(At, 0, 1); PG8_STAGE(PG8_SA(0, 0), a2, voffA);
            PG8_BAR; PG8_WAIT_L(0); PG8_MMA(1, 0, At, B0); PG8_BAR; PG8_SCHED;
            PG8_STAGE(PG8_SB(0, 1), b2 + hstep, voffB);
            PG8_WAIT_V(6); PG8_BAR; PG8_MMA(1, 1, At, B1); PG8_BAR;
            PG8_LDB(B0, 1, 0); PG8_SCHED; PG8_LDA(At, 1, 0); PG8_STAGE(PG8_SA(0, 1), a2 + hstep, voffA);
            PG8_WAIT_L(8); PG8_BAR; PG8_WAIT_L(0); PG8_MMA(0, 0, At, B0); PG8_BAR; PG8_SCHED;
            PG8_LDB(B1, 1, 1); PG8_STAGE(PG8_SB(1, 0), b3, voffB);
            PG8_BAR; PG8_WAIT_L(0); PG8_MMA(0, 1, At, B1); PG8_BAR;
            PG8_LDA(At, 1, 1); PG8_STAGE(PG8_SA(1, 0), a3, voffA);
            PG8_BAR; PG8_WAIT_L(0); PG8_MMA(1, 0, At, B0); PG8_BAR; PG8_SCHED;
            PG8_STAGE(PG8_SB(1, 1), b3 + hstep, voffB);
            PG8_WAIT_V(6); PG8_BAR; PG8_MMA(1, 1, At, B1); PG8_BAR;
            }
        }
        if constexpr (ALIGN_EPI) { if (wr == 0) PG8_BAR; }
        if constexpr (!Epi::AFTER_DRAIN) { E(acc, cur, wr, wc, fr, fq); S.done(cur); }
        if (!has_next) break;
#pragma unroll
        for (int a = 0; a < 2; ++a)
#pragma unroll
            for (int b = 0; b < 2; ++b)
#pragma unroll
                for (int m = 0; m < 4; ++m)
#pragma unroll
                    for (int n = 0; n < 2; ++n) acc[a][b][m][n] = (f32x4){0.f, 0.f, 0.f, 0.f};
        cur = nxt; cA = nA; cB = nB; ++ui;
        if constexpr (ALIGN_EPI) { if (wr == 1) PG8_BAR; }
    }
    PG8_WAIT_V(0);
    if constexpr (!ALIGN_EPI) { if (wr == 0) PG8_BAR; }
    PG8_BAR;
    if constexpr (Epi::AFTER_DRAIN) { E.fused(acc, cur, wr, wc, fr, fq, lds, wid, lane); S.done(cur); }
#undef PG8_SA
#undef PG8_SB
#undef PG8_STAGE
#undef PG8_LDA
#undef PG8_LDB
#undef PG8_MMA
#undef PG8_WAIT_V
#undef PG8_WAIT_L
#undef PG8_BAR
#undef PG8_SCHED
}
}

namespace att {
typedef unsigned short bf16_t;
typedef short bf16x8 __attribute__((ext_vector_type(8)));
typedef short s16x4 __attribute__((ext_vector_type(4)));
typedef short v4i16_t __attribute__((ext_vector_type(4)));
typedef float f32x16 __attribute__((ext_vector_type(16)));
typedef float f32x4 __attribute__((ext_vector_type(4)));
typedef unsigned u32x4 __attribute__((ext_vector_type(4)));
typedef unsigned u32x2 __attribute__((ext_vector_type(2)));
#define ALAS __attribute__((address_space(3)))
constexpr int SEQ = 16384, ZP = 3072, QROWS = 128, NQB = SEQ / QROWS, DMODEL = 1024;
constexpr int STAGE = 32768, XB_OFF = 65536;
constexpr float EPS = 1e-6f;

__device__ __forceinline__ int crow(int r, int hi) { return (r & 3) + 8 * (r >> 2) + 4 * hi; }
typedef float f32x2_t __attribute__((ext_vector_type(2))); typedef __bf16 bf16x2_t __attribute__((ext_vector_type(2)));
__device__ __forceinline__ unsigned cvtpk(float lo, float hi) { f32x2_t v = {lo, hi}; bf16x2_t b = __builtin_convertvector(v, bf16x2_t); return __builtin_bit_cast(unsigned, b); }
__device__ __forceinline__ void glds16(const void* gsrc, unsigned lds_dst) { unsigned keep;
    asm volatile("s_mov_b32 %0, m0\n\ts_mov_b32 m0, %2\n\ts_nop 0\n\tglobal_load_lds_dwordx4 %1, off\n\ts_mov_b32 m0, %0" : "=&s"(keep) : "v"(gsrc), "s"(lds_dst) : "memory"); }
#define ATT_WAIT_BAR(N) asm volatile("s_waitcnt vmcnt(" #N ") lgkmcnt(0)\n\ts_barrier" ::: "memory")
__device__ __forceinline__ s16x4 vtr(const ALAS unsigned char* p) { return __builtin_bit_cast(s16x4, __builtin_amdgcn_ds_read_tr16_b64_v4i16((ALAS v4i16_t*)p)); }

__device__ __forceinline__ void attn_unit(ALAS unsigned char* lds, const bf16_t* __restrict__ z, bf16_t* __restrict__ A2, int h, int qb,
                                          float negM, float lam, const float* __restrict__ ogain, float oscale) {
    int tid_ = threadIdx.x; asm volatile("" : "+v"(tid_));
    const int tid = tid_, lane = tid & 63, wid = __builtin_amdgcn_readfirstlane(tid >> 6), r32 = lane & 31, hi = lane >> 5;
    const int m = wid & 1, g = wid >> 1;
    const int q0 = qb * QROWS, qrow = q0 + 32 * g + r32;
    bf16x8 qf[4];
    { const bf16_t* qp = z + (size_t)qrow * ZP + h * 128 + m * 64 + hi * 8;
#pragma unroll
      for (int d0 = 0; d0 < 4; ++d0) qf[d0] = *(const bf16x8*)(qp + 16 * d0); }
    const int NT = 2 * qb + 2;
    const int tlast = (q0 + 32 * g + 31) >> 6;
    const unsigned lds0 = (unsigned)(uintptr_t)lds;
    const int kkey0 = 16 * (wid & 3) + (lane >> 3);
    const bf16_t* ksrc = z + (size_t)kkey0 * ZP + 512 + h * 128 + (wid >> 2) * 64 + (((lane & 7) ^ ((kkey0 >> 1) & 7)) * 8);
    const bf16_t* ksrc2 = z + (size_t)(kkey0 + 8) * ZP + 512 + h * 128 + (wid >> 2) * 64 + (((lane & 7) ^ (((kkey0 + 8) >> 1) & 7)) * 8);
    const bf16_t* vsrc = z + (size_t)(16 * (wid & 3) + (lane >> 2)) * ZP + 1024 + h * 128 + (2 * (wid >> 2)) * 32 + (lane & 3) * 8;
    const unsigned kdst = lds0 + (wid >> 2) * 8192 + (2 * (wid & 3)) * 1024, vdst = lds0 + 65536 + (2 * (wid >> 2)) * 4096 + (wid & 3) * 1024;
#define ATT_DMAK(t) do { const size_t o_ = (size_t)(t) * 64 * ZP; const unsigned sb_ = (unsigned)((((t) >> 1) & 1) * 32768 + ((t) & 1) * 16384); \
        glds16(ksrc + o_, (unsigned)__builtin_amdgcn_readfirstlane(kdst + sb_)); glds16(ksrc2 + o_, (unsigned)__builtin_amdgcn_readfirstlane(kdst + sb_ + 1024)); } while (0)
#define ATT_DMAV(t) do { const size_t o_ = (size_t)(t) * 64 * ZP; const unsigned sb_ = (unsigned)(((t) & 3) * 16384); \
        glds16(vsrc + o_, (unsigned)__builtin_amdgcn_readfirstlane(vdst + sb_)); glds16(vsrc + o_ + 32, (unsigned)__builtin_amdgcn_readfirstlane(vdst + sb_ + 4096)); } while (0)
    asm volatile("" : "+v"(qf[0]), "+v"(qf[1]), "+v"(qf[2]), "+v"(qf[3]));
    asm volatile("s_waitcnt vmcnt(0)" ::: "memory");
    ATT_DMAK(0); ATT_DMAK(1); ATT_DMAV(0);
    ATT_WAIT_BAR(0);
    f32x16 o[4];
#pragma unroll
    for (int d = 0; d < 4; ++d)
#pragma unroll
        for (int r = 0; r < 16; ++r) o[d][r] = 0.f;
    float l = 0.f;
    const int kfx = (r32 >> 1) & 7;
    const int kro = m * 8192 + r32 * 128;
    const int kq0 = kro + ((0 + hi) ^ kfx) * 16, kq1 = kro + ((2 + hi) ^ kfx) * 16, kq2 = kro + ((4 + hi) ^ kfx) * 16, kq3 = kro + ((6 + hi) ^ kfx) * 16;
    const int vro = 65536 + ((lane >> 4) & 1) * 32 + (lane & 3) * 8 + (4 * hi + ((lane & 15) >> 2)) * 64;
    const f32x16 zero16 = {0.f, 0.f, 0.f, 0.f, 0.f, 0.f, 0.f, 0.f, 0.f, 0.f, 0.f, 0.f, 0.f, 0.f, 0.f, 0.f};
#define ATT_SBAR() __builtin_amdgcn_sched_barrier(0)
#define ATT_PIN(x) asm volatile("" : "+v"(x))
#define ATT_EX(v) __builtin_amdgcn_exp2f(v)
#define ATT_MF(a, b, c) __builtin_amdgcn_mfma_f32_32x32x16_bf16(a, b, c, 0, 0, 0)
#define ATT_VLOAD(arr, db) do { _Pragma("unroll") for (int ks_ = 0; ks_ < 4; ++ks_) { arr[2 * ks_] = vtr(Vb + (db) * 4096 + ks_ * 1024); arr[2 * ks_ + 1] = vtr(Vb + (db) * 4096 + ks_ * 1024 + 512); } } while (0)
#define ATT_VF(arr, ks) (bf16x8){arr[2 * (ks)][0], arr[2 * (ks)][1], arr[2 * (ks)][2], arr[2 * (ks)][3], arr[2 * (ks) + 1][0], arr[2 * (ks) + 1][1], arr[2 * (ks) + 1][2], arr[2 * (ks) + 1][3]}
#define ATT_PWB(PW, ks) __builtin_bit_cast(bf16x8, PW[ks])
#define ATT_QK(t) ATT_QKH(t, do { } while (0), do { } while (0))
#define ATT_QKH(t, HOOK, HOOK2) do { const ALAS unsigned char* Kb = lds + (((t) >> 1) & 1) * 32768 + ((t) & 1) * 16384; bf16x8 kf[4], kg2[4]; \
        kf[0] = *(const ALAS bf16x8*)(Kb + kq0); kf[1] = *(const ALAS bf16x8*)(Kb + kq0 + 4096); kf[2] = *(const ALAS bf16x8*)(Kb + kq1); kf[3] = *(const ALAS bf16x8*)(Kb + kq1 + 4096); \
        kg2[0] = *(const ALAS bf16x8*)(Kb + kq2); kg2[1] = *(const ALAS bf16x8*)(Kb + kq2 + 4096); kg2[2] = *(const ALAS bf16x8*)(Kb + kq3); kg2[3] = *(const ALAS bf16x8*)(Kb + kq3 + 4096); \
        ATT_SBAR(); HOOK; ATT_SBAR(); \
        c0 = ATT_MF(kf[0], qf[0], zero16); c1 = ATT_MF(kf[1], qf[0], zero16); c0 = ATT_MF(kf[2], qf[1], c0); c1 = ATT_MF(kf[3], qf[1], c1); \
        c0 = ATT_MF(kg2[0], qf[2], c0); c1 = ATT_MF(kg2[1], qf[2], c1); c0 = ATT_MF(kg2[2], qf[3], c0); c1 = ATT_MF(kg2[3], qf[3], c1); \
        ATT_SBAR(); HOOK2; ATT_SBAR(); } while (0)
#define ATT_SOFTMAX(PWN, t) do { \
        _Pragma("unroll") for (int r = 0; r < 16; ++r) { c0[r] = ATT_EX(c0[r]); c1[r] = ATT_EX(c1[r]); } \
        if ((t) == tlast) { const int kb_ = 64 * (t) + 4 * hi; \
            _Pragma("unroll") for (int r = 0; r < 16; ++r) { const int kk_ = kb_ + (r & 3) + 8 * (r >> 2); if (kk_ > qrow) c0[r] = 0.f; if (kk_ + 32 > qrow) c1[r] = 0.f; } } \
        float sa_ = 0.f, sb_ = 0.f; \
        _Pragma("unroll") for (int r = 0; r < 16; ++r) { sa_ += c0[r]; sb_ += c1[r]; } \
        l += sa_ + sb_; \
        _Pragma("unroll") for (int j = 0; j < 4; ++j) { \
            PWN[0][j] = cvtpk(c0[2 * j], c0[2 * j + 1]); PWN[1][j] = cvtpk(c0[8 + 2 * j], c0[8 + 2 * j + 1]); \
            PWN[2][j] = cvtpk(c1[2 * j], c1[2 * j + 1]); PWN[3][j] = cvtpk(c1[8 + 2 * j], c1[8 + 2 * j + 1]); } \
        ATT_SBAR(); } while (0)
#define ATT_PV(PWP, tt) do { const ALAS unsigned char* Vb = lds + ((tt) & 3) * 16384 + vro; s16x4 va[8], vb[8]; \
        ATT_VLOAD(va, 0); ATT_VLOAD(vb, 1); ATT_SBAR(); \
        _Pragma("unroll") for (int ks = 0; ks < 4; ++ks) o[0] = ATT_MF(ATT_VF(va, ks), ATT_PWB(PWP, ks), o[0]); \
        ATT_SBAR(); ATT_VLOAD(va, 2); ATT_SBAR(); \
        _Pragma("unroll") for (int ks = 0; ks < 4; ++ks) o[1] = ATT_MF(ATT_VF(vb, ks), ATT_PWB(PWP, ks), o[1]); \
        ATT_SBAR(); ATT_VLOAD(vb, 3); ATT_SBAR(); \
        _Pragma("unroll") for (int ks = 0; ks < 4; ++ks) o[2] = ATT_MF(ATT_VF(va, ks), ATT_PWB(PWP, ks), o[2]); \
        _Pragma("unroll") for (int ks = 0; ks < 4; ++ks) o[3] = ATT_MF(ATT_VF(vb, ks), ATT_PWB(PWP, ks), o[3]); \
        ATT_SBAR(); } while (0)
#define ATT_GAP(MFS, X, B, WORD) do { MFS; X[B] = ATT_EX(X[B]); X[(B) + 1] = ATT_EX(X[(B) + 1]); sacc += X[B]; sacc += X[(B) + 1]; WORD = cvtpk(X[B], X[(B) + 1]); ATT_PIN(sacc); ATT_SBAR(); } while (0)
#define ATT_PV_FUSED(PWP, PWN, t) do { const ALAS unsigned char* Vb = lds + (((t) - 1) & 3) * 16384 + vro; s16x4 va[8], vb[8]; float sacc = 0.f; \
        ATT_VLOAD(va, 0); ATT_VLOAD(vb, 1); ATT_SBAR(); \
        ATT_GAP(o[0] = ATT_MF(ATT_VF(va, 0), ATT_PWB(PWP, 0), o[0]), c0, 0, PWN[0][0]);  ATT_GAP(o[0] = ATT_MF(ATT_VF(va, 1), ATT_PWB(PWP, 1), o[0]), c0, 2, PWN[0][1]); \
        ATT_GAP(o[0] = ATT_MF(ATT_VF(va, 2), ATT_PWB(PWP, 2), o[0]), c0, 4, PWN[0][2]);  ATT_GAP(o[0] = ATT_MF(ATT_VF(va, 3), ATT_PWB(PWP, 3), o[0]), c0, 6, PWN[0][3]); \
        ATT_VLOAD(va, 2); ATT_SBAR(); \
        ATT_GAP(o[1] = ATT_MF(ATT_VF(vb, 0), ATT_PWB(PWP, 0), o[1]), c0, 8, PWN[1][0]);  ATT_GAP(o[1] = ATT_MF(ATT_VF(vb, 1), ATT_PWB(PWP, 1), o[1]), c0, 10, PWN[1][1]); \
        ATT_GAP(o[1] = ATT_MF(ATT_VF(vb, 2), ATT_PWB(PWP, 2), o[1]), c0, 12, PWN[1][2]); ATT_GAP(o[1] = ATT_MF(ATT_VF(vb, 3), ATT_PWB(PWP, 3), o[1]), c0, 14, PWN[1][3]); \
        ATT_VLOAD(vb, 3); ATT_SBAR(); \
        ATT_GAP(o[2] = ATT_MF(ATT_VF(va, 0), ATT_PWB(PWP, 0), o[2]), c1, 0, PWN[2][0]);  ATT_GAP(o[2] = ATT_MF(ATT_VF(va, 1), ATT_PWB(PWP, 1), o[2]), c1, 2, PWN[2][1]); \
        ATT_GAP(o[2] = ATT_MF(ATT_VF(va, 2), ATT_PWB(PWP, 2), o[2]), c1, 4, PWN[2][2]);  ATT_GAP(o[2] = ATT_MF(ATT_VF(va, 3), ATT_PWB(PWP, 3), o[2]), c1, 6, PWN[2][3]); \
        ATT_GAP(o[3] = ATT_MF(ATT_VF(vb, 0), ATT_PWB(PWP, 0), o[3]), c1, 8, PWN[3][0]);  ATT_GAP(o[3] = ATT_MF(ATT_VF(vb, 1), ATT_PWB(PWP, 1), o[3]), c1, 10, PWN[3][1]); \
        ATT_GAP(o[3] = ATT_MF(ATT_VF(vb, 2), ATT_PWB(PWP, 2), o[3]), c1, 12, PWN[3][2]); ATT_GAP(o[3] = ATT_MF(ATT_VF(vb, 3), ATT_PWB(PWP, 3), o[3]), c1, 14, PWN[3][3]); \
        l += sacc; } while (0)
#ifndef ATT_PROBE
#define ATT_PROBE 0
#endif
#if ATT_PROBE == 1
#define ATT_PROBE_CODE(t) do { const ALAS unsigned char* Kb = lds + ((t) & 3) * 32768 + kq0; bf16x8 kx = *(const ALAS bf16x8*)(Kb); f32x16 x0 = zero16, x1 = zero16; \
        _Pragma("unroll") for (int d0_ = 0; d0_ < 4; ++d0_) { x0 = ATT_MF(kx, qf[d0_], x0); x1 = ATT_MF(kx, qf[d0_], x1); } asm volatile("" :: "v"(x0), "v"(x1)); ATT_SBAR(); } while (0)
#elif ATT_PROBE == 2
#define ATT_PROBE_CODE(t) do { f32x16 x0 = c0, x1 = c1; _Pragma("unroll") for (int r = 0; r < 16; ++r) { x0[r] = ATT_EX(x0[r]); x1[r] = ATT_EX(x1[r]); } asm volatile("" :: "v"(x0), "v"(x1)); ATT_SBAR(); } while (0)
#elif ATT_PROBE == 3
#define ATT_PROBE_CODE(t) do { const ALAS unsigned char* Vb = lds + (((t) - 1) & 3) * 32768 + vro; const ALAS unsigned char* Kb = lds + ((t) & 3) * 32768 + kq0; s16x4 xa[8], xb_[8]; ATT_VLOAD(xa, 0); ATT_VLOAD(xb_, 1); \
        bf16x8 kx[8]; _Pragma("unroll") for (int i_ = 0; i_ < 8; ++i_) kx[i_] = *(const ALAS bf16x8*)(Kb + (i_ >> 1) * 2048 + (i_ & 1) * 512); \
        _Pragma("unroll") for (int i_ = 0; i_ < 8; ++i_) asm volatile("" :: "v"(xa[i_]), "v"(xb_[i_]), "v"(kx[i_])); ATT_SBAR(); } while (0)
#elif ATT_PROBE == 4
#define ATT_PROBE_CODE(t) do { asm volatile("s_waitcnt lgkmcnt(0)\n\ts_barrier" ::: "memory"); } while (0)
#else
#define ATT_PROBE_CODE(t) do { } while (0)
#endif
#define ATT_STEPX(PWP, PWN, t) do { \
        if ((t) < tlast) { ATT_QK(t); ATT_PROBE_CODE(t); ATT_PV_FUSED(PWP, PWN, t); } \
        else if ((t) == tlast) { ATT_QK(t); ATT_PV(PWP, (t) - 1); ATT_SOFTMAX(PWN, t); } \
        else if ((t) == tlast + 1) { ATT_PV(PWP, (t) - 1); } } while (0)
    f32x16 c0, c1;
    u32x4 pwa[4], pwb[4];
#pragma unroll
    for (int j = 0; j < 4; ++j) { pwa[j] = (u32x4){0u, 0u, 0u, 0u}; pwb[j] = (u32x4){0u, 0u, 0u, 0u}; }
    if (NT > 2) { ATT_DMAK(2); ATT_DMAK(3); }
    ATT_DMAV(1); if (NT > 2) { ATT_DMAV(2); }
    ATT_QK(0); ATT_SOFTMAX(pwa, 0);
    ATT_STEPX(pwa, pwb, 1);
    ATT_WAIT_BAR(0);
    int t = 2;
    for (; t + 5 <= NT; t += 2) {
        ATT_QKH(t, do { ATT_DMAK(t + 2); ATT_DMAK(t + 3); } while (0), do { ATT_DMAV(t + 1); ATT_DMAV(t + 2); } while (0)); ATT_PV_FUSED(pwb, pwa, t);
        ATT_QK(t + 1); ATT_PV_FUSED(pwa, pwb, t + 1);
        ATT_WAIT_BAR(0);
    }
    for (; t < NT; t += 2) {
        if (t + 2 < NT) { ATT_DMAK(t + 2); ATT_DMAK(t + 3); }
        ATT_DMAV(t + 1); if (t + 2 < NT) { ATT_DMAV(t + 2); }
        ATT_STEPX(pwb, pwa, t); ATT_STEPX(pwa, pwb, t + 1);
        ATT_WAIT_BAR(0);
    }
    if (tlast == NT - 1) { ATT_PV(pwb, NT - 1); }
    ATT_WAIT_BAR(0);
    l += __shfl_xor(l, 32);
    const float inv = 1.0f / l;
    ALAS float* xb = (ALAS float*)(lds + g * 16384);
    if (m == 1) {
        const float f = inv * lam;
#pragma unroll
        for (int db = 0; db < 4; ++db)
#pragma unroll
            for (int r = 0; r < 16; ++r) xb[(32 * db + crow(r, hi)) * 32 + r32] = o[db][r] * f;
    }
    __syncthreads();
    if (m == 0) {
        float ssq = 0.f;
#pragma unroll
        for (int db = 0; db < 4; ++db)
#pragma unroll
            for (int r = 0; r < 16; ++r) { const float v = o[db][r] * inv - xb[(32 * db + crow(r, hi)) * 32 + r32]; o[db][r] = v; ssq += v * v; }
        ssq += __shfl_xor(ssq, 32);
        const float rn = __builtin_amdgcn_rsqf(ssq * (1.0f / 128.0f) + EPS) * oscale;
        bf16_t* op = A2 + (size_t)qrow * DMODEL + h * 128;
#pragma unroll
        for (int db = 0; db < 4; ++db)
#pragma unroll
            for (int rq = 0; rq < 4; ++rq) {
                const int d = 32 * db + 8 * rq + 4 * hi;
                const f32x4 gv = *(const f32x4*)(ogain + d);
                u32x2 w; w.x = cvtpk(o[db][4 * rq] * rn * gv[0], o[db][4 * rq + 1] * rn * gv[1]); w.y = cvtpk(o[db][4 * rq + 2] * rn * gv[2], o[db][4 * rq + 3] * rn * gv[3]);
                *(u32x2*)(op + d) = w;
            }
    }
    __syncthreads();
}

__device__ __forceinline__ void unpack8(const u32x4 w, float (&f)[8]) {
    f[0] = __uint_as_float(w.x << 16); f[1] = __uint_as_float(w.x & 0xffff0000u); f[2] = __uint_as_float(w.y << 16); f[3] = __uint_as_float(w.y & 0xffff0000u);
    f[4] = __uint_as_float(w.z << 16); f[5] = __uint_as_float(w.z & 0xffff0000u); f[6] = __uint_as_float(w.w << 16); f[7] = __uint_as_float(w.w & 0xffff0000u);
}
__device__ __forceinline__ void conv_phase(const bf16_t* __restrict__ z, bf16_t* __restrict__ A2, const float* __restrict__ cw, const float* __restrict__ cb, const float* __restrict__ cgn,
                                           int gwave, int ngw, int lane) {
    const int c0 = lane * 8;
    float w0[8], w1[8], w2[8], bb[8], gg[8];
#pragma unroll
    for (int j = 0; j < 8; ++j) { w0[j] = cw[c0 + j]; w1[j] = cw[512 + c0 + j]; w2[j] = cw[1024 + c0 + j]; bb[j] = cb[c0 + j]; gg[j] = cgn[c0 + j]; }
    for (int task = gwave; task < SEQ / 8; task += ngw) {
        const int t0 = task * 8;
        float u1[8], u2[8];
#pragma unroll
        for (int j = 0; j < 8; ++j) { u1[j] = 0.f; u2[j] = 0.f; }
        if (t0 >= 2) {
            float a[8], b[8];
            unpack8(*(const u32x4*)(z + (size_t)(t0 - 2) * ZP + 2048 + c0), a); unpack8(*(const u32x4*)(z + (size_t)(t0 - 2) * ZP + 2560 + c0), b);
#pragma unroll
            for (int j = 0; j < 8; ++j) u2[j] = a[j] * b[j];
            unpack8(*(const u32x4*)(z + (size_t)(t0 - 1) * ZP + 2048 + c0), a); unpack8(*(const u32x4*)(z + (size_t)(t0 - 1) * ZP + 2560 + c0), b);
#pragma unroll
            for (int j = 0; j < 8; ++j) u1[j] = a[j] * b[j];
        }
        u32x4 GB[8], GC[8], HC[8];
#pragma unroll
        for (int tt = 0; tt < 8; ++tt) { const size_t ro = (size_t)(t0 + tt) * ZP; GB[tt] = *(const u32x4*)(z + ro + 1536 + c0); GC[tt] = *(const u32x4*)(z + ro + 2048 + c0); HC[tt] = *(const u32x4*)(z + ro + 2560 + c0); }
#pragma unroll
        for (int tt = 0; tt < 8; ++tt) {
            float gb[8], gc[8], hc[8], y[8];
            unpack8(GB[tt], gb); unpack8(GC[tt], gc); unpack8(HC[tt], hc);
            float ss = 0.f;
#pragma unroll
            for (int j = 0; j < 8; ++j) { const float u = gc[j] * hc[j]; y[j] = gb[j] * (w0[j] * u2[j] + w1[j] * u1[j] + w2[j] * u + bb[j]); ss += y[j] * y[j]; u2[j] = u1[j]; u1[j] = u; }
            ss += __shfl_xor(ss, 1); ss += __shfl_xor(ss, 2); ss += __shfl_xor(ss, 4);
            const float rn = __builtin_amdgcn_rsqf(ss * (1.0f / 64.0f) + EPS);
            u32x4 w;
            w.x = cvtpk(y[0] * rn * gg[0], y[1] * rn * gg[1]); w.y = cvtpk(y[2] * rn * gg[2], y[3] * rn * gg[3]);
            w.z = cvtpk(y[4] * rn * gg[4], y[5] * rn * gg[5]); w.w = cvtpk(y[6] * rn * gg[6], y[7] * rn * gg[7]);
            *(u32x4*)(A2 + (size_t)(t0 + tt) * DMODEL + 512 + c0) = w;
        }
    }
}
}

#define LAS __attribute__((address_space(3)))
typedef unsigned short bf16;
typedef unsigned v4u __attribute__((ext_vector_type(4)));
typedef float f32x4 __attribute__((ext_vector_type(4)));
constexpr int NWAVES = 8;
#ifndef PHMASK
#define PHMASK 0xFFFF
#endif
#ifndef RUNMASK
#define RUNMASK 0xFFFFu
#endif
constexpr int M = 16384, D = 1024, FF = 2816, NIN = 3072, DPLE = 256, DEPTH = 2;
constexpr int LDS_BYTES = 147456;
constexpr size_t LW = 45613056;
constexpr size_t OW_GU1 = 0, OW_D1 = 11534336, OW_IN = 17301504, OW_OUT = 23592960, OW_GU2 = 25690112, OW_D2 = 37224448, OW_PG = 42991616, OW_PP = 45088768;
constexpr size_t WS_PB = 2 * LW;
constexpr size_t WS_XB = WS_PB + 16777216;
constexpr size_t WS_SSA = WS_XB + 33554432, WS_SSB = WS_SSA + 1048576;
constexpr size_t WS_A2 = WS_SSB + 1048576;
constexpr size_t WS_Z = WS_A2 + 33554432;
constexpr size_t WS_END = WS_Z + 100663296;

__device__ __forceinline__ unsigned f2bf(float f) { unsigned u = __builtin_bit_cast(unsigned, f); return (u + 0x7fffu + ((u >> 16) & 1u)) >> 16; }
__device__ __forceinline__ unsigned pk2(float lo, float hi) { return f2bf(lo) | (f2bf(hi) << 16); }
__device__ __forceinline__ float wave_sum(float v) {
#pragma unroll
    for (int o = 1; o < 64; o <<= 1) v += __shfl_xor(v, o);
    return v;
}
__device__ __forceinline__ float wave_max(float v) {
#pragma unroll
    for (int o = 1; o < 64; o <<= 1) v = fmaxf(v, __shfl_xor(v, o));
    return v;
}
__device__ __forceinline__ void tr_item(const float* __restrict__ W, int K, int N, bf16* __restrict__ WT, int mode, const float* __restrict__ gain, LAS float* scr, int item, int lane) {
    const int nblk = N / 32, kb = item / nblk, nb = item % nblk, k0 = 64 * kb, n0 = 32 * nb;
    float wv[32];
#pragma unroll
    for (int i = 0; i < 32; ++i) { const int kk = 2 * i + (lane >> 5); wv[i] = __builtin_nontemporal_load(W + (size_t)(k0 + kk) * N + n0 + (lane & 31)); }
    if (gain) {
#pragma unroll
        for (int i = 0; i < 32; ++i) wv[i] *= gain[k0 + 2 * i + (lane >> 5)];
    }
#pragma unroll
    for (int i = 0; i < 32; ++i) scr[(2 * i + (lane >> 5)) * 33 + (lane & 31)] = wv[i];
    asm volatile("s_waitcnt lgkmcnt(0)" ::: "memory");
    int rb = n0;
    if (mode == 1) rb = 256 * (n0 >> 7) + (n0 & 127);
    else if (mode == 2) rb = 256 * (n0 >> 7) + 128 + (n0 & 127);
    else if (mode == 3) rb = (n0 & ~255) + 128 * ((n0 >> 5) & 1) + 32 * ((n0 >> 6) & 3);
    const int c = lane & 7;
#pragma unroll
    for (int j = 0; j < 4; ++j) { const int n = (lane >> 3) + 8 * j; const LAS float* s = scr + (8 * c) * 33 + n;
        v4u o; o.x = pk2(s[0 * 33], s[1 * 33]); o.y = pk2(s[2 * 33], s[3 * 33]); o.z = pk2(s[4 * 33], s[5 * 33]); o.w = pk2(s[6 * 33], s[7 * 33]);
        *(v4u*)(WT + (size_t)(rb + n) * K + k0 + 8 * c) = o; }
    asm volatile("s_waitcnt lgkmcnt(0)" ::: "memory");
}

#define XB_TMO      128
#define XB_XCNT(j)  (256  + 64 * (j))
#define XB_XSUB(j)  (1280 + 64 * (j))
#define XB_XGEN(j)  (2304 + 64 * (j))
#define XB_TOP      3328
#define XB_TOPGEN   3392
#define XCD_BAR_WORDS 3456
#define XB_SPIN_CAP (1u << 20)

__device__ __forceinline__ unsigned xb_ld(unsigned* p)              { return __hip_atomic_load(p, __ATOMIC_RELAXED, __HIP_MEMORY_SCOPE_AGENT); }
__device__ __forceinline__ unsigned xb_add(unsigned* p, unsigned v) { return __hip_atomic_fetch_add(p, v, __ATOMIC_RELAXED, __HIP_MEMORY_SCOPE_AGENT); }
__device__ __forceinline__ unsigned xb_xcc_id() { return (unsigned)__builtin_amdgcn_s_getreg((3 << 11) | 20) & 0xFu; }
#define XB_SPIN(cond, bar) do { unsigned _sp = 0; while (cond) { __builtin_amdgcn_s_sleep(1); \
    if ((++_sp & 255u) == 0u) { if (xb_ld(&(bar)[XB_TMO])) break; if (_sp > XB_SPIN_CAP) { atomicAdd(&(bar)[XB_TMO], 1u); break; } } } } while (0)

struct XcdBarrier {
    unsigned* bar; unsigned x;
    volatile LAS unsigned* st;
};

__device__ __forceinline__ XcdBarrier xcd_barrier_post(unsigned* bar, volatile LAS unsigned* st) {
    XcdBarrier b; b.bar = bar; b.x = xb_xcc_id(); b.st = st;
    if (threadIdx.x == 0) (void)xb_add(&bar[XB_XCNT(b.x)], 1u);
    return b;
}
__device__ __forceinline__ void xcd_barrier_complete(unsigned* bar, unsigned x, unsigned& nloc, unsigned& nx) {
    const unsigned G = gridDim.x * gridDim.y * gridDim.z;
    unsigned sum, cnt, mine, sp = 0u;
    for (;;) {
        sum = 0u; cnt = 0u; mine = 0u;
#pragma unroll
        for (unsigned j = 0; j < 16; ++j) { const unsigned c = xb_ld(&bar[XB_XCNT(j)]); sum += c; cnt += (c > 0u) ? 1u : 0u; mine = (j == x) ? c : mine; }
        if (sum == G) break;
        __builtin_amdgcn_s_sleep(1);
        if ((++sp & 255u) == 0u) { if (xb_ld(&bar[XB_TMO])) break; if (sp > XB_SPIN_CAP) { atomicAdd(&bar[XB_TMO], 1u); break; } }
    }
    nloc = mine > 0u ? mine : 1u; nx = cnt > 0u ? cnt : 1u;
}

__device__ __forceinline__ void xcd_barrier(const XcdBarrier& b) {
    asm volatile("s_waitcnt vmcnt(0)" ::: "memory");
    __syncthreads();
    if (threadIdx.x == 0) {
        unsigned* bar = b.bar;
        __builtin_amdgcn_s_waitcnt(0);
        unsigned nloc = b.st[0], nx = b.st[1];
        if (nloc == 0u) { xcd_barrier_complete(bar, b.x, nloc, nx); b.st[0] = nloc; b.st[1] = nx; }
        const unsigned old = xb_add(&bar[XB_XSUB(b.x)], 1u);
        const unsigned gen = old / nloc;
        if (old + 1u == (gen + 1u) * nloc) {
            __builtin_amdgcn_fence(__ATOMIC_RELEASE, "agent");
            asm volatile("s_waitcnt vmcnt(0)" ::: "memory");
            const unsigned og = xb_add(&bar[XB_TOP], 1u);
            const unsigned tg = og / nx;
            if (og + 1u == (tg + 1u) * nx) xb_add(&bar[XB_TOPGEN], 1u);
            else XB_SPIN(xb_ld(&bar[XB_TOPGEN]) == tg, bar);
            __builtin_amdgcn_fence(__ATOMIC_ACQUIRE, "agent");
            xb_add(&bar[XB_XGEN(b.x)], 1u);
            asm volatile("s_waitcnt vmcnt(0)" ::: "memory");
        } else {
            XB_SPIN(xb_ld(&bar[XB_XGEN(b.x)]) == gen, bar);
            __builtin_amdgcn_fence(__ATOMIC_ACQUIRE, "agent");
            asm volatile("s_waitcnt vmcnt(0)" ::: "memory");
        }
    }
    __syncthreads();
}

constexpr size_t WS_BAR = WS_END;
constexpr int MISC_OFF = 131072 + 512;
#define CONVERT_ITEMS(Lc, it0, it1, gwx, ngwx) do { \
        bf16* wlc = (bf16*)(ws + (size_t)(Lc) * LW); const size_t oF = (size_t)(Lc) * D * FF, oS = (size_t)(Lc) * D * D; \
        for (int it = (it0) + (gwx); it < (it1); it += (ngwx)) { \
            int r = it; \
            if (r < I_F) { tr_item(KA->in[3] + oF, D, FF, (bf16*)((unsigned char*)wlc + OW_GU1), 1, KA->in[2] + (Lc) * D, scr, r, lane); continue; } r -= I_F; \
            if (r < I_F) { tr_item(KA->in[4] + oF, D, FF, (bf16*)((unsigned char*)wlc + OW_GU1), 2, KA->in[2] + (Lc) * D, scr, r, lane); continue; } r -= I_F; \
            if (r < I_F) { tr_item(KA->in[5] + oF, FF, D, (bf16*)((unsigned char*)wlc + OW_D1), 0, nullptr, scr, r, lane); continue; } r -= I_F; \
            if (r < I_IN) { tr_item(KA->in[7] + (size_t)(Lc) * D * NIN, D, NIN, (bf16*)((unsigned char*)wlc + OW_IN), 3, KA->in[6] + (Lc) * D, scr, r, lane); continue; } r -= I_IN; \
            if (r < I_SQ) { tr_item(KA->in[18] + oS, D, D, (bf16*)((unsigned char*)wlc + OW_OUT), 0, nullptr, scr, r, lane); continue; } r -= I_SQ; \
            if (r < I_F) { tr_item(KA->in[20] + oF, D, FF, (bf16*)((unsigned char*)wlc + OW_GU2), 1, KA->in[19] + (Lc) * D, scr, r, lane); continue; } r -= I_F; \
            if (r < I_F) { tr_item(KA->in[21] + oF, D, FF, (bf16*)((unsigned char*)wlc + OW_GU2), 2, KA->in[19] + (Lc) * D, scr, r, lane); continue; } r -= I_F; \
            if (r < I_F) { tr_item(KA->in[22] + oF, FF, D, (bf16*)((unsigned char*)wlc + OW_D2), 0, nullptr, scr, r, lane); continue; } r -= I_F; \
            if (r < I_SQ) { tr_item(KA->in[24] + oS, D, D, (bf16*)((unsigned char*)wlc + OW_PG), 0, KA->in[23] + (Lc) * D, scr, r, lane); continue; } r -= I_SQ; \
            tr_item(KA->in[25] + (size_t)(Lc) * DPLE * D, DPLE, D, (bf16*)((unsigned char*)wlc + OW_PP), 0, nullptr, scr, r, lane); \
        } } while (0)
constexpr int I_F = 1408, I_IN = 1536, I_SQ = 512, I_PP = 128;
constexpr int ITEMS = 6 * I_F + I_IN + 2 * I_SQ + I_PP;
constexpr int ITEMS_GU1 = 2 * I_F;
constexpr int ITEMS_SPLIT = 7424;
struct Args { const float* in[26]; float* out; unsigned char* ws; unsigned mask; unsigned pad; };
typedef const __attribute__((address_space(4))) Args* KP;
#define KARGS() ((KP)__builtin_amdgcn_kernarg_segment_ptr())
#define PH_BEGIN KP KA = KARGS(); int Ll = L, Gl = G, bxl = bx, tidl = threadIdx.x; asm volatile("" : "+s"(KA), "+s"(Ll), "+s"(Gl), "+s"(bxl), "+v"(tidl)); unsigned char* ws = KA->ws; float* X = KA->out; \
    const int lane = tidl & 63, wave = __builtin_amdgcn_readfirstlane(tidl >> 6), vcu = (Gl % 8 == 0) ? (bxl % 8) * (Gl / 8) + bxl / 8 : bxl, gw = vcu * NWAVES + wave, NGW = Gl * NWAVES; (void)lane; (void)gw; (void)NGW; \
    const unsigned char* wl = ws + (size_t)Ll * LW; (void)wl; (void)Gl; (void)bxl; (void)X;
#define WPTR(off) ((const bf16*)(wl + (off)))
#define XB ((bf16*)(ws + WS_XB))
#define XB4 ((bf16*)(ws))
#define SSA ((float*)(ws + WS_SSA))
#define SSB ((float*)(ws + WS_SSB))
#define A2 ((bf16*)(ws + WS_A2))
#define Z ((bf16*)(ws + WS_Z))
#define PB ((bf16*)(ws + WS_PB))
#define Hb Z


__global__ void __launch_bounds__(NWAVES * 64, 2) fwd_mega(Args a) {
    extern __shared__ __attribute__((aligned(16))) unsigned char lds_raw[];
    LAS unsigned char* lds = (LAS unsigned char*)lds_raw;
    cg::grid_group grid = cg::this_grid();
    const int G = gridDim.x, bx = blockIdx.x;
    if (threadIdx.x < 2) ((volatile LAS unsigned*)(lds + MISC_OFF))[threadIdx.x] = 0u;
    if (threadIdx.x == 0) (void)xb_add((unsigned*)(KARGS()->ws + WS_BAR) + XB_XCNT(xb_xcc_id()), 1u);
#define GRID_BAR() do { XcdBarrier b_; b_.bar = (unsigned*)(KARGS()->ws + WS_BAR); b_.x = xb_xcc_id(); b_.st = (volatile LAS unsigned*)(lds + MISC_OFF); xcd_barrier(b_); } while (0)

#ifndef REP_P0
#define REP_P0 1
#endif
#ifndef REP_S1
#define REP_S1 1
#endif
#ifndef REP_S2
#define REP_S2 1
#endif
#ifndef REP_S3
#define REP_S3 1
#endif
#ifndef REP_S5
#define REP_S5 1
#endif
#ifndef REP_S8
#define REP_S8 1
#endif
    for (int rep = 0; rep < REP_P0; ++rep)
    if ((PHMASK & 1) && (KARGS()->mask & 1u)) {
        const int L = 0; PH_BEGIN (void)Ll;
        LAS float* scr = (LAS float*)(lds + wave * 16384);
        CONVERT_ITEMS(0, 0, ITEMS_GU1, gw, NGW);
        if (Gl != 256) { CONVERT_ITEMS(0, ITEMS_GU1, ITEMS, gw, NGW); CONVERT_ITEMS(1, 0, ITEMS, gw, NGW); }
        const float* xin = KA->in[0];
        for (int row = gw; row < M; row += NGW) {
            const f32x4* xr = (const f32x4*)(xin + (size_t)row * D) + lane;
            f32x4 v[4]; float s = 0.f;
#pragma unroll
            for (int j = 0; j < 4; ++j) { v[j] = xr[64 * j]; s += (v[j][0] * v[j][0] + v[j][1] * v[j][1]) + (v[j][2] * v[j][2] + v[j][3] * v[j][3]); }
            s = wave_sum(s);
            unsigned long long* o8 = (unsigned long long*)(XB + (size_t)row * D) + lane;
#pragma unroll
            for (int j = 0; j < 4; ++j) o8[64 * j] = (unsigned long long)pk2(v[j][0], v[j][1]) | ((unsigned long long)pk2(v[j][2], v[j][3]) << 32);
            if (lane < 16) SSB[(size_t)row * 16 + lane] = (lane == 0) ? s : 0.f;
        }
        const float* pin = KA->in[1];
        for (size_t i = (size_t)(bxl * (NWAVES * 64) + tidl) * 8; i < (size_t)DEPTH * M * DPLE; i += (size_t)Gl * NWAVES * 64 * 8) {
            const f32x4 v0 = *(const f32x4*)(pin + i), v1 = *(const f32x4*)(pin + i + 4);
            v4u o; o.x = pk2(v0[0], v0[1]); o.y = pk2(v0[2], v0[3]); o.z = pk2(v1[0], v1[1]); o.w = pk2(v1[2], v1[3]);
            *(v4u*)(PB + i) = o;
        }
    }
    GRID_BAR();
    if (KARGS()->mask == 0xC0FFEE11u) grid.sync();

#pragma unroll 1
    for (int L = 0; L < DEPTH; ++L) {
        for (int rep = 0; rep < REP_S1; ++rep)
        if ((PHMASK & 2) && (KARGS()->mask & 2u)) { PH_BEGIN pg8::Gemm g{Ll == 0 ? XB : XB4, WPTR(OW_GU1), M, 2 * FF, D}; pg8::StaticOrder S; S.init(M, 2 * FF, Gl, bxl); pg8::EpiSwiglu E{Hb, SSB};
          pg8::gemm_phase<pg8::EpiSwiglu, pg8::StaticOrder, true, true>(lds, g, S, E);
          if (Gl == 256 && bxl >= 128) { LAS float* scr = (LAS float*)(lds + wave * 16384); CONVERT_ITEMS(Ll, ITEMS_GU1, ITEMS, (bxl - 128) * NWAVES + wave, 128 * NWAVES); } }
        GRID_BAR();
        for (int rep = 0; rep < REP_S2; ++rep)
        if ((PHMASK & 4) && (KARGS()->mask & 4u)) { PH_BEGIN pg8::Gemm g{Hb, WPTR(OW_D1), M, D, FF}; pg8::StaticOrder S; S.init(M, D, Gl, bxl); pg8::EpiResid E{(Ll == 0 && rep == 0) ? KA->in[0] : X, X, XB, SSA, rep == 0 ? 0.5f : 0.0f};
          pg8::gemm_phase<pg8::EpiResid, pg8::StaticOrder, true, true>(lds, g, S, E); }
        GRID_BAR();
        for (int rep = 0; rep < REP_S3; ++rep)
        if ((PHMASK & 8) && (KARGS()->mask & 8u)) { PH_BEGIN pg8::Gemm g{XB, WPTR(OW_IN), M, NIN, D}; pg8::StaticOrder S; S.init(M, NIN, Gl, bxl); pg8::EpiWin E{Z, SSA, KA->in[8] + Ll * 64, KA->in[9] + Ll * 64};
          pg8::gemm_phase<pg8::EpiWin, pg8::StaticOrder, true, true>(lds, g, S, E); }
        GRID_BAR();
        if ((PHMASK & 16) && (KARGS()->mask & 16u)) {
            PH_BEGIN
            att::conv_phase(Z, A2, KA->in[15] + Ll * 3 * 512, KA->in[16] + Ll * 512, KA->in[17] + Ll * 512, gw, NGW, lane);
            const float lam_init = (Ll == 0) ? 0.2f : (0.8f - 0.6f * 0.7408182206817179f);
            const float d1 = wave_sum(KA->in[10][Ll * 64 + lane] * KA->in[11][Ll * 64 + lane]);
            const float d2 = wave_sum(KA->in[12][Ll * 64 + lane] * KA->in[13][Ll * 64 + lane]);
            const float lam = __expf(d1) - __expf(d2) + lam_init;
            const float mq = wave_max(fabsf(KA->in[8][Ll * 64 + lane])), mk = wave_max(fabsf(KA->in[9][Ll * 64 + lane]));
            const float negM = -(64.0f * pg8::QSCALE * mq * mk);
#ifndef REP_ATT
#define REP_ATT 1
#endif
            for (int rep = 0; rep < REP_ATT; ++rep)
            for (int j = vcu; j < 256; j += Gl) {
                const int h = j >> 6, s = j & 63;
#pragma unroll 1
                for (int k2 = 0; k2 < 2; ++k2) att::attn_unit(lds, Z, A2, h, k2 == 0 ? 127 - s : s, negM, lam, KA->in[14] + Ll * 128, 1.0f - lam_init);
            }
        }
        GRID_BAR();
        for (int rep = 0; rep < REP_S5; ++rep)
        if ((PHMASK & 32) && (KARGS()->mask & 32u)) { PH_BEGIN pg8::Gemm g{A2, WPTR(OW_OUT), M, D, D}; pg8::StaticOrder S; S.init(M, D, Gl, bxl); pg8::EpiResid E{X, X, XB, SSB, rep == 0 ? 1.0f : 0.0f};
          pg8::gemm_phase<pg8::EpiResid, pg8::StaticOrder, true, true>(lds, g, S, E); }
        GRID_BAR();
        if ((PHMASK & 64) && (KARGS()->mask & 64u)) { PH_BEGIN pg8::Gemm g{XB, WPTR(OW_GU2), M, 2 * FF, D}; pg8::StaticOrder S; S.init(M, 2 * FF, Gl, bxl); pg8::EpiSwiglu E{Hb, SSB};
          pg8::gemm_phase<pg8::EpiSwiglu, pg8::StaticOrder, true, true>(lds, g, S, E); }
        if ((PHMASK & 128) && (KARGS()->mask & 128u)) { PH_BEGIN int Kp = DPLE; asm volatile("" : "+s"(Kp)); pg8::Gemm g{PB + (size_t)Ll * M * DPLE, WPTR(OW_PP), M, D, Kp}; pg8::StaticOrder S; const bool half_ = (Gl == 256); S.init(M, D, half_ ? 128 : Gl, half_ ? (bxl >= 128 ? bxl - 128 : 1 << 20) : bxl); pg8::EpiPlain E{A2};
          pg8::gemm_phase<pg8::EpiPlain, pg8::StaticOrder, true, true>(lds, g, S, E);
          if (Ll + 1 < DEPTH && Gl == 256 && bxl >= 128) { LAS float* scr = (LAS float*)(lds + wave * 16384); CONVERT_ITEMS(Ll + 1, 0, ITEMS_GU1, (bxl - 128) * NWAVES + wave, 128 * NWAVES); } }
        GRID_BAR();
        if ((PHMASK & 256) && (KARGS()->mask & 256u)) { PH_BEGIN pg8::Gemm g{Hb, WPTR(OW_D2), M, D, FF}; pg8::StaticOrder S; S.init(M, D, Gl, bxl); pg8::EpiResid E{X, X, XB, SSA, 0.5f};
          pg8::gemm_phase<pg8::EpiResid, pg8::StaticOrder, true, true>(lds, g, S, E); }
        GRID_BAR();
        for (int rep = 0; rep < REP_S8; ++rep)
        if ((PHMASK & 512) && (KARGS()->mask & 512u)) { PH_BEGIN pg8::Gemm g{XB, WPTR(OW_PG), M, D, D}; pg8::StaticOrder S; S.init(M, D, Gl, bxl); pg8::EpiPle E{X, XB4, SSA, SSB, A2, rep == 0 ? 1.0f : 0.0f, Ll + 1 < DEPTH};
          pg8::gemm_phase<pg8::EpiPle, pg8::StaticOrder, true, true>(lds, g, S, E); }
        if (L + 1 < DEPTH) GRID_BAR();
    }
}

extern "C" void kernel_launch(void* const* d_in, const int* in_sizes, int n_in, void* d_out, int out_size, void* d_ws, size_t ws_size, hipStream_t stream) {
    static int grid = 0;
    if (grid == 0) {
        if (n_in != 26 || out_size != M * D || ws_size < WS_END + 16384) { fprintf(stderr, "kernel_launch: unexpected shapes (n_in %d, out %d, ws %zu < %zu)\n", n_in, out_size, ws_size, (size_t)WS_END); grid = -1; return; }
        int dev = 0, cus = 0, per_cu = 0;
        hipGetDevice(&dev);
        hipDeviceGetAttribute(&cus, hipDeviceAttributeMultiprocessorCount, dev);
        if (hipFuncSetAttribute((const void*)fwd_mega, hipFuncAttributeMaxDynamicSharedMemorySize, LDS_BYTES) != hipSuccess) { fprintf(stderr, "kernel_launch: hipFuncSetAttribute failed\n"); grid = -1; return; }
        if (hipOccupancyMaxActiveBlocksPerMultiprocessor(&per_cu, (const void*)fwd_mega, NWAVES * 64, LDS_BYTES) != hipSuccess || per_cu < 1) { fprintf(stderr, "kernel_launch: occupancy query gave %d\n", per_cu); per_cu = 1; }
        (void)hipGetLastError();
        grid = cus;
    }
    if (grid < 0) return;
    Args a{};
    for (int i = 0; i < 26; ++i) a.in[i] = (const float*)d_in[i];
    a.out = (float*)d_out; a.ws = (unsigned char*)d_ws; a.mask = RUNMASK; a.pad = 0;
    void* args[] = {&a};
    if (hipMemsetAsync((char*)d_ws + WS_BAR, 0, 16384, stream) != hipSuccess) { fprintf(stderr, "kernel_launch: hipMemsetAsync of the barrier words failed\n"); return; }
    hipError_t e = hipLaunchCooperativeKernel((const void*)fwd_mega, dim3(grid), dim3(NWAVES * 64), args, LDS_BYTES, stream);
    if (e != hipSuccess) fprintf(stderr, "kernel_launch: cooperative launch failed: %s (grid %d)\n", hipGetErrorString(e), grid);
}
```

```cpp
#include <hip/hip_runtime.h>
#include <hip/hip_cooperative_groups.h>
#include <cstdio>
#include <cstdint>
namespace cg = cooperative_groups;
namespace pg8 {
#define PG8_LAS __attribute__((address_space(3)))
typedef unsigned short bf16_t;
typedef short bf16x8 __attribute__((ext_vector_type(8)));
typedef float f32x4 __attribute__((ext_vector_type(4)));
typedef unsigned u32x4 __attribute__((ext_vector_type(4)));
constexpr int BM = 256, BK = 64, HALF = 128, HTB = HALF * BK * 2  , STAGE_BYTES = 8 * HTB, NXCD = 8, WGM = 8;

__host__ __device__ __forceinline__ int lds_byte(int r, int c) { const int st = (r >> 4) * 2 + (c >> 5), rr = r & 15, cc = c & 31, ob = rr * 64 + cc * 2; return st * 1024 + (ob ^ (((ob >> 9) & 1) << 5)); }
__host__ __device__ __forceinline__ void stage_rc(int b, int& R, int& C) { const int st = b / 1024, sb = b % 1024, swz = sb ^ (((sb >> 9) & 1) << 5); R = (st >> 1) * 16 + swz / 64; C = (st & 1) * 32 + (swz % 64) / 2; }
__host__ __device__ __forceinline__ int perm32(int rho) { const int n = rho >> 4, i = rho & 15; return 8 * (i >> 2) + 4 * n + (i & 3); }

struct Unit { int pm, pn; };
struct Gemm { const bf16_t* A; const bf16_t* Bt; int M, N, K; };

struct StaticOrder {
    int nM, nN, nwg, G, c;
    __host__ __device__ void init(int M, int N, int G_, int c_) { nM = M / BM; nN = N / BM; nwg = nM * nN; G = G_; c = c_; }
    __host__ __device__ bool next(int i, Unit& u) const {
        const long L = (long)i * G + c; if (L >= nwg) return false;
        int wgid = (int)L; { const int q = nwg / NXCD, r = nwg % NXCD, xcd = wgid % NXCD, off = wgid / NXCD; wgid = (xcd < r ? xcd * (q + 1) : r * (q + 1) + (xcd - r) * q) + off; }
        const int nig = WGM * nN, gid = wgid / nig, fm = gid * WGM, gsz = (nM - fm) < WGM ? (nM - fm) : WGM;
        u.pm = fm + ((wgid % nig) % gsz); u.pn = (wgid % nig) / gsz; return true;
    }
    __device__ __forceinline__ void a_ready(const Unit&) const {}
    __device__ __forceinline__ void done(const Unit&) const {}
};

__device__ __forceinline__ unsigned cvt_pk_bf16(float lo, float hi) { unsigned r; asm volatile("v_cvt_pk_bf16_f32 %0, %1, %2" : "=v"(r) : "v"(lo), "v"(hi)); return r; }
typedef float f32x2 __attribute__((ext_vector_type(2)));

typedef unsigned u32x4_t __attribute__((ext_vector_type(4)));
constexpr float RMS_EPS = 1e-6f;
constexpr float LOG2E = 1.4426950408889634f;
constexpr float QSCALE = 0.125f * LOG2E;
constexpr int DM = 1024, DFF = 2816, DIN = 3072;

__device__ __forceinline__ float row_rstd(const float* ss, int row) {
    const f32x4* p = (const f32x4*)(ss + (size_t)row * 16);
    const f32x4 a = p[0], b = p[1], c = p[2], d = p[3];
    const float s = ((a[0] + a[1]) + (a[2] + a[3])) + ((b[0] + b[1]) + (b[2] + b[3])) + ((c[0] + c[1]) + (c[2] + c[3])) + ((d[0] + d[1]) + (d[2] + d[3]));
    return __builtin_amdgcn_rsqf(s * (1.0f / DM) + RMS_EPS);
}
__device__ __forceinline__ void rows_rstd(const float* ss, int row0, int fq, float (&rs)[2][4]) {
    f32x4 q[2][4];
#pragma unroll
    for (int ai = 0; ai < 2; ++ai)
#pragma unroll
        for (int m = 0; m < 4; ++m) q[ai][m] = *(const f32x4*)(ss + (size_t)(row0 + ai * HALF + m * 16) * 16 + 4 * fq);
#pragma unroll
    for (int ai = 0; ai < 2; ++ai)
#pragma unroll
        for (int m = 0; m < 4; ++m) { float t = (q[ai][m][0] + q[ai][m][1]) + (q[ai][m][2] + q[ai][m][3]); t += __shfl_xor(t, 16); t += __shfl_xor(t, 32); rs[ai][m] = __builtin_amdgcn_rsqf(t * (1.0f / DM) + RMS_EPS); }
}
__device__ __forceinline__ float sigmoidf_fast(float a) { return __builtin_amdgcn_rcpf(1.0f + __builtin_amdgcn_exp2f(-a * LOG2E)); }
__device__ __forceinline__ u32x4_t pack8(const f32x4 v0, const f32x4 v1) {
    u32x4_t w; w.x = cvt_pk_bf16(v0[0], v0[1]); w.y = cvt_pk_bf16(v0[2], v0[3]); w.z = cvt_pk_bf16(v1[0], v1[1]); w.w = cvt_pk_bf16(v1[2], v1[3]); return w;
}
__device__ __forceinline__ float bf_lo(unsigned w) { return __uint_as_float(w << 16); }
__device__ __forceinline__ float bf_hi(unsigned w) { return __uint_as_float(w & 0xffff0000u); }

struct EpiSwiglu {
    static constexpr bool PERM = true, AFTER_DRAIN = false;
    bf16_t* H; const float* ss;
    __device__ __forceinline__ void operator()(const f32x4 (&acc)[2][2][4][2], const Unit& u, int wr, int wc, int fr, int fq) const {
        const int hcol = u.pn * 128 + wc * 32 + 8 * fq;
        float rsv[2][4]; rows_rstd(ss, u.pm * BM + wr * 64 + fr, fq, rsv);
#pragma unroll
        for (int ai = 0; ai < 2; ++ai)
#pragma unroll
            for (int m = 0; m < 4; ++m) {
                const int row = u.pm * BM + ai * HALF + wr * 64 + m * 16 + fr;
                const float rs = rsv[ai][m];
                const float k1 = -rs * LOG2E, k2 = rs * rs;
                f32x2 g[4], up[4], e[4], r[4];
#pragma unroll
                for (int p = 0; p < 4; ++p) { g[p] = (f32x2){acc[ai][0][m][p >> 1][2 * (p & 1)], acc[ai][0][m][p >> 1][2 * (p & 1) + 1]}; up[p] = (f32x2){acc[ai][1][m][p >> 1][2 * (p & 1)], acc[ai][1][m][p >> 1][2 * (p & 1) + 1]}; }
#pragma unroll
                for (int p = 0; p < 4; ++p) { const f32x2 t = g[p] * k1; e[p].x = __builtin_amdgcn_exp2f(t.x); e[p].y = __builtin_amdgcn_exp2f(t.y); }
#pragma unroll
                for (int p = 0; p < 4; ++p) { const f32x2 d = e[p] + 1.0f; r[p].x = __builtin_amdgcn_rcpf(d.x); r[p].y = __builtin_amdgcn_rcpf(d.y); }
                f32x4 o[2];
#pragma unroll
                for (int p = 0; p < 4; ++p) { const f32x2 v = (g[p] * up[p]) * (r[p] * k2); o[p >> 1][2 * (p & 1)] = v.x; o[p >> 1][2 * (p & 1) + 1] = v.y; }
                *(u32x4_t*)(H + (size_t)row * DFF + hcol) = pack8(o[0], o[1]);
            }
    }
};

struct EpiResid {
    static constexpr bool PERM = true, AFTER_DRAIN = false;
    const float* xin; float* xout; bf16_t* xb; float* ssw; float coef;
    __device__ __forceinline__ void operator()(const f32x4 (&acc)[2][2][4][2], const Unit& u, int wr, int wc, int fr, int fq) const {
        const size_t colb = (size_t)u.pn * BM + wc * 32 + 8 * fq;
        const int rowb = u.pm * BM + wr * 64 + fr;
        f32x4 a[2][2][2][2];
#define RES_LOAD(buf, b) do { _Pragma("unroll") for (int mm_ = 0; mm_ < 2; ++mm_) _Pragma("unroll") for (int bj_ = 0; bj_ < 2; ++bj_) { \
            const size_t off_ = (size_t)(rowb + ((b) >> 1) * HALF + (2 * ((b) & 1) + mm_) * 16) * DM + colb + bj_ * HALF; \
            a[buf][mm_][bj_][0] = *(const f32x4*)(xin + off_); a[buf][mm_][bj_][1] = *(const f32x4*)(xin + off_ + 4); } } while (0)
#define RES_STORE(buf, b) do { _Pragma("unroll") for (int mm_ = 0; mm_ < 2; ++mm_) { const int ai_ = (b) >> 1, m_ = 2 * ((b) & 1) + mm_; const int row_ = rowb + ai_ * HALF + m_ * 16; float sq_ = 0.f; \
            _Pragma("unroll") for (int bj_ = 0; bj_ < 2; ++bj_) { const size_t off_ = (size_t)row_ * DM + colb + bj_ * HALF; \
                const f32x4 v0_ = a[buf][mm_][bj_][0] + acc[ai_][bj_][m_][0] * coef, v1_ = a[buf][mm_][bj_][1] + acc[ai_][bj_][m_][1] * coef; \
                *(f32x4*)(xout + off_) = v0_; *(f32x4*)(xout + off_ + 4) = v1_; *(u32x4_t*)(xb + off_) = pack8(v0_, v1_); \
                sq_ += (v0_[0] * v0_[0] + v0_[1] * v0_[1]) + (v0_[2] * v0_[2] + v0_[3] * v0_[3]) + (v1_[0] * v1_[0] + v1_[1] * v1_[1]) + (v1_[2] * v1_[2] + v1_[3] * v1_[3]); } \
            sq_ += __shfl_xor(sq_, 16); sq_ += __shfl_xor(sq_, 32); if (fq == 0) ssw[(size_t)row_ * 16 + u.pn * 4 + wc] = sq_; } } while (0)
#define RES_FENCE() asm volatile("" ::: "memory")
        RES_LOAD(0, 0); RES_LOAD(1, 1); RES_FENCE();
        RES_STORE(0, 0); RES_FENCE(); RES_LOAD(0, 2); RES_FENCE();
        RES_STORE(1, 1); RES_FENCE(); RES_LOAD(1, 3); RES_FENCE();
        RES_STORE(0, 2); RES_FENCE();
        RES_STORE(1, 3);
#undef RES_LOAD
#undef RES_STORE
#undef RES_FENCE
    }
};

struct EpiWin {
    static constexpr bool PERM = true, AFTER_DRAIN = false;
    bf16_t* Z; const float* ss; const float* qg; const float* kg;
    __device__ __forceinline__ void operator()(const f32x4 (&acc)[2][2][4][2], const Unit& u, int wr, int wc, int fr, int fq) const {
        const bool isqk = u.pn < 4; const bool isq = u.pn < 2;
        float rsv[2][4]; rows_rstd(ss, u.pm * BM + wr * 64 + fr, fq, rsv);
        f32x4 gn[2][2];
#pragma unroll
        for (int bj = 0; bj < 2; ++bj)
#pragma unroll
            for (int n = 0; n < 2; ++n) {
                if (isqk) { const float* gp = (isq ? qg : kg) + 32 * bj + 8 * fq + 4 * n; gn[bj][n] = *(const f32x4*)gp; if (isq) gn[bj][n] = gn[bj][n] * QSCALE; }
                else gn[bj][n] = (f32x4){1.f, 1.f, 1.f, 1.f};
            }
#pragma unroll
        for (int ai = 0; ai < 2; ++ai)
#pragma unroll
            for (int m = 0; m < 4; ++m) {
                const int row = u.pm * BM + ai * HALF + wr * 64 + m * 16 + fr;
                const float rs = rsv[ai][m];
                f32x4 v[2][2]; float sq = 0.f;
#pragma unroll
                for (int bj = 0; bj < 2; ++bj)
#pragma unroll
                    for (int n = 0; n < 2; ++n) { v[bj][n] = acc[ai][bj][m][n] * rs; const f32x4 t = v[bj][n]; sq += (t[0] * t[0] + t[1] * t[1]) + (t[2] * t[2] + t[3] * t[3]); }
                float rn = 1.f;
                if (isqk) { sq += __shfl_xor(sq, 16); sq += __shfl_xor(sq, 32); rn = __builtin_amdgcn_rsqf(sq * (1.0f / 64.0f) + RMS_EPS); }
#pragma unroll
                for (int bj = 0; bj < 2; ++bj) {
                    const f32x4 o0 = v[bj][0] * rn * gn[bj][0], o1 = v[bj][1] * rn * gn[bj][1];
                    *(u32x4_t*)(Z + (size_t)row * DIN + u.pn * BM + 64 * wc + 32 * bj + 8 * fq) = pack8(o0, o1);
                }
            }
    }
};

struct EpiPlain {
    static constexpr bool PERM = true, AFTER_DRAIN = false;
    bf16_t* O;
    __device__ __forceinline__ void operator()(const f32x4 (&acc)[2][2][4][2], const Unit& u, int wr, int wc, int fr, int fq) const {
#pragma unroll
        for (int ai = 0; ai < 2; ++ai)
#pragma unroll
            for (int m = 0; m < 4; ++m) {
                const int row = u.pm * BM + ai * HALF + wr * 64 + m * 16 + fr;
#pragma unroll
                for (int bj = 0; bj < 2; ++bj)
                    *(u32x4_t*)(O + (size_t)row * DM + u.pn * BM + bj * HALF + wc * 32 + 8 * fq) = pack8(acc[ai][bj][m][0], acc[ai][bj][m][1]);
            }
    }
};

struct EpiPle {
    static constexpr bool PERM = true, AFTER_DRAIN = false;
    float* x; bf16_t* xb; const float* ssr; float* ssw; const bf16_t* pp; float coef; bool aux;
    __device__ __forceinline__ void operator()(const f32x4 (&acc)[2][2][4][2], const Unit& u, int wr, int wc, int fr, int fq) const {
        float rsv[2][4]; rows_rstd(ssr, u.pm * BM + wr * 64 + fr, fq, rsv);
        const size_t colb = (size_t)u.pn * BM + wc * 32 + 8 * fq;
#pragma unroll
        for (int ai = 0; ai < 2; ++ai)
#pragma unroll
            for (int m = 0; m < 4; ++m) {
                const int row = u.pm * BM + ai * HALF + wr * 64 + m * 16 + fr;
                const size_t off0 = (size_t)row * DM + colb;
                f32x4 a[2][2]; u32x4_t pw[2];
#pragma unroll
                for (int bj = 0; bj < 2; ++bj) { a[bj][0] = *(const f32x4*)(x + off0 + bj * HALF); a[bj][1] = *(const f32x4*)(x + off0 + bj * HALF + 4); pw[bj] = *(const u32x4_t*)(pp + off0 + bj * HALF); }
                asm volatile("" ::: "memory");
                const float rs = rsv[ai][m];
                float sq = 0.f;
#pragma unroll
                for (int bj = 0; bj < 2; ++bj) {
                    const size_t off = off0 + bj * HALF;
                    const u32x4_t w = pw[bj];
                    const f32x4 p0 = (f32x4){bf_lo(w.x), bf_hi(w.x), bf_lo(w.y), bf_hi(w.y)}, p1 = (f32x4){bf_lo(w.z), bf_hi(w.z), bf_lo(w.w), bf_hi(w.w)};
                    f32x4 v0, v1;
#pragma unroll
                    for (int j = 0; j < 4; ++j) { v0[j] = a[bj][0][j] + coef * sigmoidf_fast(acc[ai][bj][m][0][j] * rs) * p0[j]; v1[j] = a[bj][1][j] + coef * sigmoidf_fast(acc[ai][bj][m][1][j] * rs) * p1[j]; }
                    *(f32x4*)(x + off) = v0; *(f32x4*)(x + off + 4) = v1;
                    if (aux) *(u32x4_t*)(xb + off) = pack8(v0, v1);
                    sq += (v0[0] * v0[0] + v0[1] * v0[1]) + (v0[2] * v0[2] + v0[3] * v0[3]) + (v1[0] * v1[0] + v1[1] * v1[1]) + (v1[2] * v1[2] + v1[3] * v1[3]);
                }
                sq += __shfl_xor(sq, 16); sq += __shfl_xor(sq, 32);
                if (aux && fq == 0) ssw[(size_t)row * 16 + u.pn * 4 + wc] = sq;
                asm volatile("" ::: "memory");
            }
    }
};
template <class Epi, class Sched, bool ALIGN_EPI = false, bool SP2 = false>
__device__ __forceinline__ void gemm_phase(PG8_LAS unsigned char* lds, const Gemm g, const Sched& S, const Epi& E) {
    int tid_ = threadIdx.x; asm volatile("" : "+v"(tid_));
    const int tid = tid_, wid = __builtin_amdgcn_readfirstlane(tid >> 6), lane = tid & 63, wr = wid >> 2, wc = wid & 3, fr = lane & 15, fq = lane >> 4;
    const int K = g.K, nt = K / BK;
    unsigned voffA[2], voffB[2];
#pragma unroll
    for (int i = 0; i < 2; ++i) { int R, C; stage_rc(tid * 16 + i * 8192, R, C); const int Rb = Epi::PERM ? ((R & ~31) + perm32(R & 31)) : R;
        voffA[i] = (unsigned)(R * K + C) * 2u; voffB[i] = (unsigned)(Rb * K + C) * 2u; }
    const size_t kstep = (size_t)(BK * 2);
    const size_t hstep = (size_t)HALF * K * 2;
    const size_t tstep = 2 * hstep;
    const unsigned ldsw = (unsigned)wid * 1024u;
    const int aoff = lds_byte(wr * 64 + fr, fq * 8), boff = lds_byte(wc * 32 + fr, fq * 8);
#define PG8_SA(b, h) (((b) * 2 + (h)) * HTB)
#define PG8_SB(b, h) ((4 + (b) * 2 + (h)) * HTB)
#define PG8_STAGE(bufoff, gbase, voff) do { _Pragma("unroll") for (int _i = 0; _i < 2; ++_i) \
        __builtin_amdgcn_global_load_lds((const unsigned*)((const char*)(gbase) + (voff)[_i]), (PG8_LAS unsigned*)(lds + (bufoff) + ldsw + _i * 8192), 16, 0, 0); } while (0)
#define PG8_LDA(dst, b, h) do { _Pragma("unroll") for (int m = 0; m < 4; ++m) _Pragma("unroll") for (int k = 0; k < 2; ++k) dst[m][k] = *(const PG8_LAS bf16x8*)(lds + PG8_SA(b, h) + aoff + m * 2048 + k * 1024); } while (0)
#define PG8_LDB(dst, b, h) do { _Pragma("unroll") for (int n = 0; n < 2; ++n) _Pragma("unroll") for (int k = 0; k < 2; ++k) dst[n][k] = *(const PG8_LAS bf16x8*)(lds + PG8_SB(b, h) + boff + n * 2048 + k * 1024); } while (0)
#define PG8_MMA(ai, bj, At, Bt) do { __builtin_amdgcn_s_setprio(1); _Pragma("unroll") for (int m = 0; m < 4; ++m) _Pragma("unroll") for (int n = 0; n < 2; ++n) _Pragma("unroll") for (int k = 0; k < 2; ++k) \
        acc[ai][bj][m][n] = __builtin_amdgcn_mfma_f32_16x16x32_bf16(Bt[n][k], At[m][k], acc[ai][bj][m][n], 0, 0, 0); __builtin_amdgcn_s_setprio(0); } while (0)
#define PG8_WAIT_V(n) asm volatile("s_waitcnt vmcnt(" #n ")" ::: "memory")
#define PG8_WAIT_L(n) asm volatile("s_waitcnt lgkmcnt(" #n ")" ::: "memory")
#define PG8_BAR __builtin_amdgcn_s_barrier()
#define PG8_SCHED __builtin_amdgcn_sched_barrier(0)
    Unit cur, nxt; int ui = 0;
    if (!S.next(0, cur)) return;
    f32x4 acc[2][2][4][2];
#pragma unroll
    for (int a = 0; a < 2; ++a)
#pragma unroll
        for (int b = 0; b < 2; ++b)
#pragma unroll
            for (int m = 0; m < 4; ++m)
#pragma unroll
                for (int n = 0; n < 2; ++n) acc[a][b][m][n] = (f32x4){0.f, 0.f, 0.f, 0.f};
    bf16x8 At[4][2], B0[2][2], B1[2][2];
    const char* cA = (const char*)g.A + (size_t)cur.pm * tstep; const char* cB = (const char*)g.Bt + (size_t)cur.pn * tstep;
    S.a_ready(cur);
    if constexpr (SP2) {
        PG8_STAGE(PG8_SB(0, 0), cB, voffB); PG8_STAGE(PG8_SB(0, 1), cB + hstep, voffB); PG8_STAGE(PG8_SA(0, 0), cA, voffA); PG8_STAGE(PG8_SA(0, 1), cA + hstep, voffA);
        if (wr == 1) PG8_BAR;
        PG8_WAIT_V(2); PG8_BAR;
        PG8_STAGE(PG8_SB(1, 0), cB + kstep, voffB); PG8_STAGE(PG8_SA(1, 0), cA + kstep, voffA); PG8_STAGE(PG8_SB(1, 1), cB + hstep + kstep, voffB);
        PG8_WAIT_V(6); PG8_BAR;
    } else {
        PG8_STAGE(PG8_SB(0, 0), cB, voffB); PG8_STAGE(PG8_SA(0, 0), cA, voffA); PG8_STAGE(PG8_SB(0, 1), cB + hstep, voffB); PG8_STAGE(PG8_SA(0, 1), cA + hstep, voffA);
        if (wr == 1) PG8_BAR;
        PG8_WAIT_V(4); PG8_BAR;
        PG8_STAGE(PG8_SB(1, 0), cB + kstep, voffB); PG8_STAGE(PG8_SA(1, 0), cA + kstep, voffA); PG8_STAGE(PG8_SB(1, 1), cB + hstep + kstep, voffB);
        PG8_WAIT_V(6); PG8_BAR;
    }
    for (;;) {
        const bool has_next = S.next(ui + 1, nxt);
        const char* nA = has_next ? (const char*)g.A + (size_t)nxt.pm * tstep : cA; const char* nB = has_next ? (const char*)g.Bt + (size_t)nxt.pn * tstep : cB;
        for (int t = 0; t < nt; t += 2) {
            const bool last = (t == nt - 2);
            const char* a1 = cA + (size_t)(t + 1) * kstep;
            const char* a2 = last ? nA : cA + (size_t)(t + 2) * kstep; const char* b2 = last ? nB : cB + (size_t)(t + 2) * kstep;
            const char* a3 = a2 + kstep; const char* b3 = b2 + kstep;
            if (last && has_next) S.a_ready(nxt);
            if constexpr (SP2) {
            PG8_LDB(B0, 0, 0); PG8_LDB(B1, 0, 1); PG8_SCHED; PG8_LDA(At, 0, 0); PG8_STAGE(PG8_SA(1, 1), a1 + hstep, voffA);
            PG8_WAIT_V(8); PG8_WAIT_L(0); PG8_BAR; PG8_MMA(0, 0, At, B0); PG8_MMA(0, 1, At, B1); PG8_BAR; PG8_SCHED;
            PG8_LDA(At, 0, 1); PG8_STAGE(PG8_SB(0, 0), b2, voffB); PG8_STAGE(PG8_SB(0, 1), b2 + hstep, voffB); PG8_STAGE(PG8_SA(0, 0), a2, voffA);
            PG8_WAIT_V(8); PG8_WAIT_L(0); PG8_BAR; PG8_MMA(1, 0, At, B0); PG8_MMA(1, 1, At, B1); PG8_BAR; PG8_SCHED;
            PG8_LDB(B0, 1, 0); PG8_LDB(B1, 1, 1); PG8_SCHED; PG8_LDA(At, 1, 0); PG8_STAGE(PG8_SA(0, 1), a2 + hstep, voffA);
            PG8_WAIT_V(8); PG8_WAIT_L(0); PG8_BAR; PG8_MMA(0, 0, At, B0); PG8_MMA(0, 1, At, B1); PG8_BAR; PG8_SCHED;
            PG8_LDA(At, 1, 1); PG8_STAGE(PG8_SB(1, 0), b3, voffB); PG8_STAGE(PG8_SB(1, 1), b3 + hstep, voffB); PG8_STAGE(PG8_SA(1, 0), a3, voffA);
            PG8_WAIT_V(8); PG8_WAIT_L(0); PG8_BAR; PG8_MMA(1, 0, At, B0); PG8_MMA(1, 1, At, B1); PG8_BAR; PG8_SCHED;
            } else {
            PG8_LDB(B0, 0, 0); PG8_SCHED; PG8_LDA(At, 0, 0); PG8_STAGE(PG8_SA(1, 1), a1 + hstep, voffA);
            PG8_WAIT_L(8); PG8_BAR; PG8_WAIT_L(0); PG8_MMA(0, 0, At, B0); PG8_BAR; PG8_SCHED;
            PG8_LDB(B1, 0, 1); PG8_STAGE(PG8_SB(0, 0), b2, voffB);
            PG8_BAR; PG8_WAIT_L(0); PG8_MMA(0, 1, At, B1); PG8_BAR;
            PG8_LDA(At, 0, 1); PG8_STAGE(PG8_SA(0, 0), a2, voffA);
            PG8_BAR; PG8_WAIT_L(0); PG8_MMA(1, 0, At, B0); PG8_BAR; PG8_SCHED;
            PG8_STAGE(PG8_SB(0, 1), b2 + hstep, voffB);
            PG8_WAIT_V(6); PG8_BAR; PG8_MMA(1, 1, At, B1); PG8_BAR;
            PG8_LDB(B0, 1, 0); PG8_SCHED; PG8_LDA(At, 1, 0); PG8_STAGE(PG8_SA(0, 1), a2 + hstep, voffA);
            PG8_WAIT_L(8); PG8_BAR; PG8_WAIT_L(0); PG8_MMA(0, 0, At, B0); PG8_BAR; PG8_SCHED;
            PG8_LDB(B1, 1, 1); PG8_STAGE(PG8_SB(1, 0), b3, voffB);
            PG8_BAR; PG8_WAIT_L(0); PG8_MMA(0, 1, At, B1); PG8_BAR;
            PG8_LDA(At, 1, 1); PG8_STAGE(PG8_SA(1, 0), a3, voffA);
            PG8_BAR; PG8_WAIT_L(0); PG8_MMA(1, 0, At, B0); PG8_BAR; PG8_SCHED;
            PG8_STAGE(PG8_SB(1, 1), b3 + hstep, voffB);
            PG8_WAIT_V(6); PG8_BAR; PG8_MMA(1, 1, At, B1); PG8_BAR;
            }
        }
        if constexpr (ALIGN_EPI) { if (wr == 0) PG8_BAR; }
        if constexpr (!Epi::AFTER_DRAIN) { E(acc, cur, wr, wc, fr, fq); S.done(cur); }
        if (!has_next) break;
#pragma unroll
        for (int a = 0; a < 2; ++a)
#pragma unroll
            for (int b = 0; b < 2; ++b)
#pragma unroll
                for (int m = 0; m < 4; ++m)
#pragma unroll
                    for (int n = 0; n < 2; ++n) acc[a][b][m][n] = (f32x4){0.f, 0.f, 0.f, 0.f};
        cur = nxt; cA = nA; cB = nB; ++ui;
        if constexpr (ALIGN_EPI) { if (wr == 1) PG8_BAR; }
    }
    PG8_WAIT_V(0);
    if constexpr (!ALIGN_EPI) { if (wr == 0) PG8_BAR; }
    PG8_BAR;
    if constexpr (Epi::AFTER_DRAIN) { E.fused(acc, cur, wr, wc, fr, fq, lds, wid, lane); S.done(cur); }
#undef PG8_SA
#undef PG8_SB
#undef PG8_STAGE
#undef PG8_LDA
#undef PG8_LDB
#undef PG8_MMA
#undef PG8_WAIT_V
#undef PG8_WAIT_L
#undef PG8_BAR
#undef PG8_SCHED
}
}

namespace att {
typedef unsigned short bf16_t;
typedef short bf16x8 __attribute__((ext_vector_type(8)));
typedef short s16x4 __attribute__((ext_vector_type(4)));
typedef short v4i16_t __attribute__((ext_vector_type(4)));
typedef float f32x16 __attribute__((ext_vector_type(16)));
typedef float f32x4 __attribute__((ext_vector_type(4)));
typedef unsigned u32x4 __attribute__((ext_vector_type(4)));
typedef unsigned u32x2 __attribute__((ext_vector_type(2)));
#define ALAS __attribute__((address_space(3)))
constexpr int SEQ = 16384, ZP = 3072, QROWS = 128, NQB = SEQ / QROWS, DMODEL = 1024;
constexpr int STAGE = 32768, XB_OFF = 65536;
constexpr float EPS = 1e-6f;

__device__ __forceinline__ int crow(int r, int hi) { return (r & 3) + 8 * (r >> 2) + 4 * hi; }
typedef float f32x2_t __attribute__((ext_vector_type(2))); typedef __bf16 bf16x2_t __attribute__((ext_vector_type(2)));
__device__ __forceinline__ unsigned cvtpk(float lo, float hi) { f32x2_t v = {lo, hi}; bf16x2_t b = __builtin_convertvector(v, bf16x2_t); return __builtin_bit_cast(unsigned, b); }
__device__ __forceinline__ void glds16(const void* gsrc, unsigned lds_dst) { unsigned keep;
    asm volatile("s_mov_b32 %0, m0\n\ts_mov_b32 m0, %2\n\ts_nop 0\n\tglobal_load_lds_dwordx4 %1, off\n\ts_mov_b32 m0, %0" : "=&s"(keep) : "v"(gsrc), "s"(lds_dst) : "memory"); }
#define ATT_WAIT_BAR(N) asm volatile("s_waitcnt vmcnt(" #N ") lgkmcnt(0)\n\ts_barrier" ::: "memory")
__device__ __forceinline__ s16x4 vtr(const ALAS unsigned char* p) { return __builtin_bit_cast(s16x4, __builtin_amdgcn_ds_read_tr16_b64_v4i16((ALAS v4i16_t*)p)); }

__device__ __forceinline__ void attn_unit(ALAS unsigned char* lds, const bf16_t* __restrict__ z, bf16_t* __restrict__ A2, int h, int qb,
                                          float negM, float lam, const float* __restrict__ ogain, float oscale) {
    int tid_ = threadIdx.x; asm volatile("" : "+v"(tid_));
    const int tid = tid_, lane = tid & 63, wid = __builtin_amdgcn_readfirstlane(tid >> 6), r32 = lane & 31, hi = lane >> 5;
    const int m = wid & 1, g = wid >> 1;
    const int q0 = qb * QROWS, qrow = q0 + 32 * g + r32;
    bf16x8 qf[4];
    { const bf16_t* qp = z + (size_t)qrow * ZP + h * 128 + m * 64 + hi * 8;
#pragma unroll
      for (int d0 = 0; d0 < 4; ++d0) qf[d0] = *(const bf16x8*)(qp + 16 * d0); }
    const int NT = 2 * qb + 2;
    const int tlast = (q0 + 32 * g + 31) >> 6;
    const unsigned lds0 = (unsigned)(uintptr_t)lds;
    const int kkey0 = 16 * (wid & 3) + (lane >> 3);
    const bf16_t* ksrc = z + (size_t)kkey0 * ZP + 512 + h * 128 + (wid >> 2) * 64 + (((lane & 7) ^ ((kkey0 >> 1) & 7)) * 8);
    const bf16_t* ksrc2 = z + (size_t)(kkey0 + 8) * ZP + 512 + h * 128 + (wid >> 2) * 64 + (((lane & 7) ^ (((kkey0 + 8) >> 1) & 7)) * 8);
    const bf16_t* vsrc = z + (size_t)(16 * (wid & 3) + (lane >> 2)) * ZP + 1024 + h * 128 + (2 * (wid >> 2)) * 32 + (lane & 3) * 8;
    const unsigned kdst = lds0 + (wid >> 2) * 8192 + (2 * (wid & 3)) * 1024, vdst = lds0 + 65536 + (2 * (wid >> 2)) * 4096 + (wid & 3) * 1024;
#define ATT_DMAK(t) do { const size_t o_ = (size_t)(t) * 64 * ZP; const unsigned sb_ = (unsigned)((((t) >> 1) & 1) * 32768 + ((t) & 1) * 16384); \
        glds16(ksrc + o_, (unsigned)__builtin_amdgcn_readfirstlane(kdst + sb_)); glds16(ksrc2 + o_, (unsigned)__builtin_amdgcn_readfirstlane(kdst + sb_ + 1024)); } while (0)
#define ATT_DMAV(t) do { const size_t o_ = (size_t)(t) * 64 * ZP; const unsigned sb_ = (unsigned)(((t) & 3) * 16384); \
        glds16(vsrc + o_, (unsigned)__builtin_amdgcn_readfirstlane(vdst + sb_)); glds16(vsrc + o_ + 32, (unsigned)__builtin_amdgcn_readfirstlane(vdst + sb_ + 4096)); } while (0)
    asm volatile("" : "+v"(qf[0]), "+v"(qf[1]), "+v"(qf[2]), "+v"(qf[3]));
    asm volatile("s_waitcnt vmcnt(0)" ::: "memory");
    ATT_DMAK(0); ATT_DMAK(1); ATT_DMAV(0);
    ATT_WAIT_BAR(0);
    f32x16 o[4];
#pragma unroll
    for (int d = 0; d < 4; ++d)
#pragma unroll
        for (int r = 0; r < 16; ++r) o[d][r] = 0.f;
    float l = 0.f;
    const int kfx = (r32 >> 1) & 7;
    const int kro = m * 8192 + r32 * 128;
    const int kq0 = kro + ((0 + hi) ^ kfx) * 16, kq1 = kro + ((2 + hi) ^ kfx) * 16, kq2 = kro + ((4 + hi) ^ kfx) * 16, kq3 = kro + ((6 + hi) ^ kfx) * 16;
    const int vro = 65536 + ((lane >> 4) & 1) * 32 + (lane & 3) * 8 + (4 * hi + ((lane & 15) >> 2)) * 64;
    const f32x16 zero16 = {0.f, 0.f, 0.f, 0.f, 0.f, 0.f, 0.f, 0.f, 0.f, 0.f, 0.f, 0.f, 0.f, 0.f, 0.f, 0.f};
#define ATT_SBAR() __builtin_amdgcn_sched_barrier(0)
#define ATT_PIN(x) asm volatile("" : "+v"(x))
#define ATT_EX(v) __builtin_amdgcn_exp2f(v)
#define ATT_MF(a, b, c) __builtin_amdgcn_mfma_f32_32x32x16_bf16(a, b, c, 0, 0, 0)
#define ATT_VLOAD(arr, db) do { _Pragma("unroll") for (int ks_ = 0; ks_ < 4; ++ks_) { arr[2 * ks_] = vtr(Vb + (db) * 4096 + ks_ * 1024); arr[2 * ks_ + 1] = vtr(Vb + (db) * 4096 + ks_ * 1024 + 512); } } while (0)
#define ATT_VF(arr, ks) (bf16x8){arr[2 * (ks)][0], arr[2 * (ks)][1], arr[2 * (ks)][2], arr[2 * (ks)][3], arr[2 * (ks) + 1][0], arr[2 * (ks) + 1][1], arr[2 * (ks) + 1][2], arr[2 * (ks) + 1][3]}
#define ATT_PWB(PW, ks) __builtin_bit_cast(bf16x8, PW[ks])
#define ATT_QK(t) ATT_QKH(t, do { } while (0), do { } while (0))
#define ATT_QKH(t, HOOK, HOOK2) do { const ALAS unsigned char* Kb = lds + (((t) >> 1) & 1) * 32768 + ((t) & 1) * 16384; bf16x8 kf[4], kg2[4]; \
        kf[0] = *(const ALAS bf16x8*)(Kb + kq0); kf[1] = *(const ALAS bf16x8*)(Kb + kq0 + 4096); kf[2] = *(const ALAS bf16x8*)(Kb + kq1); kf[3] = *(const ALAS bf16x8*)(Kb + kq1 + 4096); \
        kg2[0] = *(const ALAS bf16x8*)(Kb + kq2); kg2[1] = *(const ALAS bf16x8*)(Kb + kq2 + 4096); kg2[2] = *(const ALAS bf16x8*)(Kb + kq3); kg2[3] = *(const ALAS bf16x8*)(Kb + kq3 + 4096); \
        ATT_SBAR(); HOOK; ATT_SBAR(); \
        c0 = ATT_MF(kf[0], qf[0], zero16); c1 = ATT_MF(kf[1], qf[0], zero16); c0 = ATT_MF(kf[2], qf[1], c0); c1 = ATT_MF(kf[3], qf[1], c1); \
        c0 = ATT_MF(kg2[0], qf[2], c0); c1 = ATT_MF(kg2[1], qf[2], c1); c0 = ATT_MF(kg2[2], qf[3], c0); c1 = ATT_MF(kg2[3], qf[3], c1); \
        ATT_SBAR(); HOOK2; ATT_SBAR(); } while (0)
#define ATT_SOFTMAX(PWN, t) do { \
        _Pragma("unroll") for (int r = 0; r < 16; ++r) { c0[r] = ATT_EX(c0[r]); c1[r] = ATT_EX(c1[r]); } \
        if ((t) == tlast) { const int kb_ = 64 * (t) + 4 * hi; \
            _Pragma("unroll") for (int r = 0; r < 16; ++r) { const int kk_ = kb_ + (r & 3) + 8 * (r >> 2); if (kk_ > qrow) c0[r] = 0.f; if (kk_ + 32 > qrow) c1[r] = 0.f; } } \
        float sa_ = 0.f, sb_ = 0.f; \
        _Pragma("unroll") for (int r = 0; r < 16; ++r) { sa_ += c0[r]; sb_ += c1[r]; } \
        l += sa_ + sb_; \
        _Pragma("unroll") for (int j = 0; j < 4; ++j) { \
            PWN[0][j] = cvtpk(c0[2 * j], c0[2 * j + 1]); PWN[1][j] = cvtpk(c0[8 + 2 * j], c0[8 + 2 * j + 1]); \
            PWN[2][j] = cvtpk(c1[2 * j], c1[2 * j + 1]); PWN[3][j] = cvtpk(c1[8 + 2 * j], c1[8 + 2 * j + 1]); } \
        ATT_SBAR(); } while (0)
#define ATT_PV(PWP, tt) do { const ALAS unsigned char* Vb = lds + ((tt) & 3) * 16384 + vro; s16x4 va[8], vb[8]; \
        ATT_VLOAD(va, 0); ATT_VLOAD(vb, 1); ATT_SBAR(); \
        _Pragma("unroll") for (int ks = 0; ks < 4; ++ks) o[0] = ATT_MF(ATT_VF(va, ks), ATT_PWB(PWP, ks), o[0]); \
        ATT_SBAR(); ATT_VLOAD(va, 2); ATT_SBAR(); \
        _Pragma("unroll") for (int ks = 0; ks < 4; ++ks) o[1] = ATT_MF(ATT_VF(vb, ks), ATT_PWB(PWP, ks), o[1]); \
        ATT_SBAR(); ATT_VLOAD(vb, 3); ATT_SBAR(); \
        _Pragma("unroll") for (int ks = 0; ks < 4; ++ks) o[2] = ATT_MF(ATT_VF(va, ks), ATT_PWB(PWP, ks), o[2]); \
        _Pragma("unroll") for (int ks = 0; ks < 4; ++ks) o[3] = ATT_MF(ATT_VF(vb, ks), ATT_PWB(PWP, ks), o[3]); \
        ATT_SBAR(); } while (0)
#define ATT_GAP(MFS, X, B, WORD) do { MFS; X[B] = ATT_EX(X[B]); X[(B) + 1] = ATT_EX(X[(B) + 1]); sacc += X[B]; sacc += X[(B) + 1]; WORD = cvtpk(X[B], X[(B) + 1]); ATT_PIN(sacc); ATT_SBAR(); } while (0)
#define ATT_PV_FUSED(PWP, PWN, t) do { const ALAS unsigned char* Vb = lds + (((t) - 1) & 3) * 16384 + vro; s16x4 va[8], vb[8]; float sacc = 0.f; \
        ATT_VLOAD(va, 0); ATT_VLOAD(vb, 1); ATT_SBAR(); \
        ATT_GAP(o[0] = ATT_MF(ATT_VF(va, 0), ATT_PWB(PWP, 0), o[0]), c0, 0, PWN[0][0]);  ATT_GAP(o[0] = ATT_MF(ATT_VF(va, 1), ATT_PWB(PWP, 1), o[0]), c0, 2, PWN[0][1]); \
        ATT_GAP(o[0] = ATT_MF(ATT_VF(va, 2), ATT_PWB(PWP, 2), o[0]), c0, 4, PWN[0][2]);  ATT_GAP(o[0] = ATT_MF(ATT_VF(va, 3), ATT_PWB(PWP, 3), o[0]), c0, 6, PWN[0][3]); \
        ATT_VLOAD(va, 2); ATT_SBAR(); \
        ATT_GAP(o[1] = ATT_MF(ATT_VF(vb, 0), ATT_PWB(PWP, 0), o[1]), c0, 8, PWN[1][0]);  ATT_GAP(o[1] = ATT_MF(ATT_VF(vb, 1), ATT_PWB(PWP, 1), o[1]), c0, 10, PWN[1][1]); \
        ATT_GAP(o[1] = ATT_MF(ATT_VF(vb, 2), ATT_PWB(PWP, 2), o[1]), c0, 12, PWN[1][2]); ATT_GAP(o[1] = ATT_MF(ATT_VF(vb, 3), ATT_PWB(PWP, 3), o[1]), c0, 14, PWN[1][3]); \
        ATT_VLOAD(vb, 3); ATT_SBAR(); \
        ATT_GAP(o[2] = ATT_MF(ATT_VF(va, 0), ATT_PWB(PWP, 0), o[2]), c1, 0, PWN[2][0]);  ATT_GAP(o[2] = ATT_MF(ATT_VF(va, 1), ATT_PWB(PWP, 1), o[2]), c1, 2, PWN[2][1]); \
        ATT_GAP(o[2] = ATT_MF(ATT_VF(va, 2), ATT_PWB(PWP, 2), o[2]), c1, 4, PWN[2][2]);  ATT_GAP(o[2] = ATT_MF(ATT_VF(va, 3), ATT_PWB(PWP, 3), o[2]), c1, 6, PWN[2][3]); \
        ATT_GAP(o[3] = ATT_MF(ATT_VF(vb, 0), ATT_PWB(PWP, 0), o[3]), c1, 8, PWN[3][0]);  ATT_GAP(o[3] = ATT_MF(ATT_VF(vb, 1), ATT_PWB(PWP, 1), o[3]), c1, 10, PWN[3][1]); \
        ATT_GAP(o[3] = ATT_MF(ATT_VF(vb, 2), ATT_PWB(PWP, 2), o[3]), c1, 12, PWN[3][2]); ATT_GAP(o[3] = ATT_MF(ATT_VF(vb, 3), ATT_PWB(PWP, 3), o[3]), c1, 14, PWN[3][3]); \
        l += sacc; } while (0)
#ifndef ATT_PROBE
#define ATT_PROBE 0
#endif
#if ATT_PROBE == 1
#define ATT_PROBE_CODE(t) do { const ALAS unsigned char* Kb = lds + ((t) & 3) * 32768 + kq0; bf16x8 kx = *(const ALAS bf16x8*)(Kb); f32x16 x0 = zero16, x1 = zero16; \
        _Pragma("unroll") for (int d0_ = 0; d0_ < 4; ++d0_) { x0 = ATT_MF(kx, qf[d0_], x0); x1 = ATT_MF(kx, qf[d0_], x1); } asm volatile("" :: "v"(x0), "v"(x1)); ATT_SBAR(); } while (0)
#elif ATT_PROBE == 2
#define ATT_PROBE_CODE(t) do { f32x16 x0 = c0, x1 = c1; _Pragma("unroll") for (int r = 0; r < 16; ++r) { x0[r] = ATT_EX(x0[r]); x1[r] = ATT_EX(x1[r]); } asm volatile("" :: "v"(x0), "v"(x1)); ATT_SBAR(); } while (0)
#elif ATT_PROBE == 3
#define ATT_PROBE_CODE(t) do { const ALAS unsigned char* Vb = lds + (((t) - 1) & 3) * 32768 + vro; const ALAS unsigned char* Kb = lds + ((t) & 3) * 32768 + kq0; s16x4 xa[8], xb_[8]; ATT_VLOAD(xa, 0); ATT_VLOAD(xb_, 1); \
        bf16x8 kx[8]; _Pragma("unroll") for (int i_ = 0; i_ < 8; ++i_) kx[i_] = *(const ALAS bf16x8*)(Kb + (i_ >> 1) * 2048 + (i_ & 1) * 512); \
        _Pragma("unroll") for (int i_ = 0; i_ < 8; ++i_) asm volatile("" :: "v"(xa[i_]), "v"(xb_[i_]), "v"(kx[i_])); ATT_SBAR(); } while (0)
#elif ATT_PROBE == 4
#define ATT_PROBE_CODE(t) do { asm volatile("s_waitcnt lgkmcnt(0)\n\ts_barrier" ::: "memory"); } while (0)
#else
#define ATT_PROBE_CODE(t) do { } while (0)
#endif
#define ATT_STEPX(PWP, PWN, t) do { \
        if ((t) < tlast) { ATT_QK(t); ATT_PROBE_CODE(t); ATT_PV_FUSED(PWP, PWN, t); } \
        else if ((t) == tlast) { ATT_QK(t); ATT_PV(PWP, (t) - 1); ATT_SOFTMAX(PWN, t); } \
        else if ((t) == tlast + 1) { ATT_PV(PWP, (t) - 1); } } while (0)
    f32x16 c0, c1;
    u32x4 pwa[4], pwb[4];
#pragma unroll
    for (int j = 0; j < 4; ++j) { pwa[j] = (u32x4){0u, 0u, 0u, 0u}; pwb[j] = (u32x4){0u, 0u, 0u, 0u}; }
    if (NT > 2) { ATT_DMAK(2); ATT_DMAK(3); }
    ATT_DMAV(1); if (NT > 2) { ATT_DMAV(2); }
    ATT_QK(0); ATT_SOFTMAX(pwa, 0);
    ATT_STEPX(pwa, pwb, 1);
    ATT_WAIT_BAR(0);
    int t = 2;
    for (; t + 5 <= NT; t += 2) {
        ATT_QKH(t, do { ATT_DMAK(t + 2); ATT_DMAK(t + 3); } while (0), do { ATT_DMAV(t + 1); ATT_DMAV(t + 2); } while (0)); ATT_PV_FUSED(pwb, pwa, t);
        ATT_QK(t + 1); ATT_PV_FUSED(pwa, pwb, t + 1);
        ATT_WAIT_BAR(0);
    }
    for (; t < NT; t += 2) {
        if (t + 2 < NT) { ATT_DMAK(t + 2); ATT_DMAK(t + 3); }
        ATT_DMAV(t + 1); if (t + 2 < NT) { ATT_DMAV(t + 2); }
        ATT_STEPX(pwb, pwa, t); ATT_STEPX(pwa, pwb, t + 1);
        ATT_WAIT_BAR(0);
    }
    if (tlast == NT - 1) { ATT_PV(pwb, NT - 1); }
    ATT_WAIT_BAR(0);
    l += __shfl_xor(l, 32);
    const float inv = 1.0f / l;
    ALAS float* xb = (ALAS float*)(lds + g * 16384);
    if (m == 1) {
        const float f = inv * lam;
#pragma unroll
        for (int db = 0; db < 4; ++db)
#pragma unroll
            for (int r = 0; r < 16; ++r) xb[(32 * db + crow(r, hi)) * 32 + r32] = o[db][r] * f;
    }
    __syncthreads();
    if (m == 0) {
        float ssq = 0.f;
#pragma unroll
        for (int db = 0; db < 4; ++db)
#pragma unroll
            for (int r = 0; r < 16; ++r) { const float v = o[db][r] * inv - xb[(32 * db + crow(r, hi)) * 32 + r32]; o[db][r] = v; ssq += v * v; }
        ssq += __shfl_xor(ssq, 32);
        const float rn = __builtin_amdgcn_rsqf(ssq * (1.0f / 128.0f) + EPS) * oscale;
        bf16_t* op = A2 + (size_t)qrow * DMODEL + h * 128;
#pragma unroll
        for (int db = 0; db < 4; ++db)
#pragma unroll
            for (int rq = 0; rq < 4; ++rq) {
                const int d = 32 * db + 8 * rq + 4 * hi;
                const f32x4 gv = *(const f32x4*)(ogain + d);
                u32x2 w; w.x = cvtpk(o[db][4 * rq] * rn * gv[0], o[db][4 * rq + 1] * rn * gv[1]); w.y = cvtpk(o[db][4 * rq + 2] * rn * gv[2], o[db][4 * rq + 3] * rn * gv[3]);
                *(u32x2*)(op + d) = w;
            }
    }
    __syncthreads();
}

__device__ __forceinline__ void unpack8(const u32x4 w, float (&f)[8]) {
    f[0] = __uint_as_float(w.x << 16); f[1] = __uint_as_float(w.x & 0xffff0000u); f[2] = __uint_as_float(w.y << 16); f[3] = __uint_as_float(w.y & 0xffff0000u);
    f[4] = __uint_as_float(w.z << 16); f[5] = __uint_as_float(w.z & 0xffff0000u); f[6] = __uint_as_float(w.w << 16); f[7] = __uint_as_float(w.w & 0xffff0000u);
}
__device__ __forceinline__ void conv_phase(const bf16_t* __restrict__ z, bf16_t* __restrict__ A2, const float* __restrict__ cw, const float* __restrict__ cb, const float* __restrict__ cgn,
                                           int gwave, int ngw, int lane) {
    const int c0 = lane * 8;
    float w0[8], w1[8], w2[8], bb[8], gg[8];
#pragma unroll
    for (int j = 0; j < 8; ++j) { w0[j] = cw[c0 + j]; w1[j] = cw[512 + c0 + j]; w2[j] = cw[1024 + c0 + j]; bb[j] = cb[c0 + j]; gg[j] = cgn[c0 + j]; }
    for (int task = gwave; task < SEQ / 8; task += ngw) {
        const int t0 = task * 8;
        float u1[8], u2[8];
#pragma unroll
        for (int j = 0; j < 8; ++j) { u1[j] = 0.f; u2[j] = 0.f; }
        if (t0 >= 2) {
            float a[8], b[8];
            unpack8(*(const u32x4*)(z + (size_t)(t0 - 2) * ZP + 2048 + c0), a); unpack8(*(const u32x4*)(z + (size_t)(t0 - 2) * ZP + 2560 + c0), b);
#pragma unroll
            for (int j = 0; j < 8; ++j) u2[j] = a[j] * b[j];
            unpack8(*(const u32x4*)(z + (size_t)(t0 - 1) * ZP + 2048 + c0), a); unpack8(*(const u32x4*)(z + (size_t)(t0 - 1) * ZP + 2560 + c0), b);
#pragma unroll
            for (int j = 0; j < 8; ++j) u1[j] = a[j] * b[j];
        }
        u32x4 GB[8], GC[8], HC[8];
#pragma unroll
        for (int tt = 0; tt < 8; ++tt) { const size_t ro = (size_t)(t0 + tt) * ZP; GB[tt] = *(const u32x4*)(z + ro + 1536 + c0); GC[tt] = *(const u32x4*)(z + ro + 2048 + c0); HC[tt] = *(const u32x4*)(z + ro + 2560 + c0); }
#pragma unroll
        for (int tt = 0; tt < 8; ++tt) {
            float gb[8], gc[8], hc[8], y[8];
            unpack8(GB[tt], gb); unpack8(GC[tt], gc); unpack8(HC[tt], hc);
            float ss = 0.f;
#pragma unroll
            for (int j = 0; j < 8; ++j) { const float u = gc[j] * hc[j]; y[j] = gb[j] * (w0[j] * u2[j] + w1[j] * u1[j] + w2[j] * u + bb[j]); ss += y[j] * y[j]; u2[j] = u1[j]; u1[j] = u; }
            ss += __shfl_xor(ss, 1); ss += __shfl_xor(ss, 2); ss += __shfl_xor(ss, 4);
            const float rn = __builtin_amdgcn_rsqf(ss * (1.0f / 64.0f) + EPS);
            u32x4 w;
            w.x = cvtpk(y[0] * rn * gg[0], y[1] * rn * gg[1]); w.y = cvtpk(y[2] * rn * gg[2], y[3] * rn * gg[3]);
            w.z = cvtpk(y[4] * rn * gg[4], y[5] * rn * gg[5]); w.w = cvtpk(y[6] * rn * gg[6], y[7] * rn * gg[7]);
            *(u32x4*)(A2 + (size_t)(t0 + tt) * DMODEL + 512 + c0) = w;
        }
    }
}
}

#define LAS __attribute__((address_space(3)))
typedef unsigned short bf16;
typedef unsigned v4u __attribute__((ext_vector_type(4)));
typedef float f32x4 __attribute__((ext_vector_type(4)));
constexpr int NWAVES = 8;
#ifndef PHMASK
#define PHMASK 0xFFFF
#endif
#ifndef RUNMASK
#define RUNMASK 0xFFFFu
#endif
constexpr int M = 16384, D = 1024, FF = 2816, NIN = 3072, DPLE = 256, DEPTH = 2;
constexpr int LDS_BYTES = 147456;
constexpr size_t LW = 45613056;
constexpr size_t OW_GU1 = 0, OW_D1 = 11534336, OW_IN = 17301504, OW_OUT = 23592960, OW_GU2 = 25690112, OW_D2 = 37224448, OW_PG = 42991616, OW_PP = 45088768;
constexpr size_t WS_PB = 2 * LW;
constexpr size_t WS_XB = WS_PB + 16777216;
constexpr size_t WS_SSA = WS_XB + 33554432, WS_SSB = WS_SSA + 1048576;
constexpr size_t WS_A2 = WS_SSB + 1048576;
constexpr size_t WS_Z = WS_A2 + 33554432;
constexpr size_t WS_END = WS_Z + 100663296;

__device__ __forceinline__ unsigned f2bf(float f) { unsigned u = __builtin_bit_cast(unsigned, f); return (u + 0x7fffu + ((u >> 16) & 1u)) >> 16; }
__device__ __forceinline__ unsigned pk2(float lo, float hi) { return f2bf(lo) | (f2bf(hi) << 16); }
__device__ __forceinline__ float wave_sum(float v) {
#pragma unroll
    for (int o = 1; o < 64; o <<= 1) v += __shfl_xor(v, o);
    return v;
}
__device__ __forceinline__ float wave_max(float v) {
#pragma unroll
    for (int o = 1; o < 64; o <<= 1) v = fmaxf(v, __shfl_xor(v, o));
    return v;
}
__device__ __forceinline__ void tr_item(const float* __restrict__ W, int K, int N, bf16* __restrict__ WT, int mode, const float* __restrict__ gain, LAS float* scr, int item, int lane) {
    const int nblk = N / 32, kb = item / nblk, nb = item % nblk, k0 = 64 * kb, n0 = 32 * nb;
    float wv[32];
#pragma unroll
    for (int i = 0; i < 32; ++i) { const int kk = 2 * i + (lane >> 5); wv[i] = __builtin_nontemporal_load(W + (size_t)(k0 + kk) * N + n0 + (lane & 31)); }
    if (gain) {
#pragma unroll
        for (int i = 0; i < 32; ++i) wv[i] *= gain[k0 + 2 * i + (lane >> 5)];
    }
#pragma unroll
    for (int i = 0; i < 32; ++i) scr[(2 * i + (lane >> 5)) * 33 + (lane & 31)] = wv[i];
    asm volatile("s_waitcnt lgkmcnt(0)" ::: "memory");
    int rb = n0;
    if (mode == 1) rb = 256 * (n0 >> 7) + (n0 & 127);
    else if (mode == 2) rb = 256 * (n0 >> 7) + 128 + (n0 & 127);
    else if (mode == 3) rb = (n0 & ~255) + 128 * ((n0 >> 5) & 1) + 32 * ((n0 >> 6) & 3);
    const int c = lane & 7;
#pragma unroll
    for (int j = 0; j < 4; ++j) { const int n = (lane >> 3) + 8 * j; const LAS float* s = scr + (8 * c) * 33 + n;
        v4u o; o.x = pk2(s[0 * 33], s[1 * 33]); o.y = pk2(s[2 * 33], s[3 * 33]); o.z = pk2(s[4 * 33], s[5 * 33]); o.w = pk2(s[6 * 33], s[7 * 33]);
        *(v4u*)(WT + (size_t)(rb + n) * K + k0 + 8 * c) = o; }
    asm volatile("s_waitcnt lgkmcnt(0)" ::: "memory");
}

#define XB_TMO      128
#define XB_XCNT(j)  (256  + 64 * (j))
#define XB_XSUB(j)  (1280 + 64 * (j))
#define XB_XGEN(j)  (2304 + 64 * (j))
#define XB_TOP      3328
#define XB_TOPGEN   3392
#define XCD_BAR_WORDS 3456
#define XB_SPIN_CAP (1u << 20)

__device__ __forceinline__ unsigned xb_ld(unsigned* p)              { return __hip_atomic_load(p, __ATOMIC_RELAXED, __HIP_MEMORY_SCOPE_AGENT); }
__device__ __forceinline__ unsigned xb_add(unsigned* p, unsigned v) { return __hip_atomic_fetch_add(p, v, __ATOMIC_RELAXED, __HIP_MEMORY_SCOPE_AGENT); }
__device__ __forceinline__ unsigned xb_xcc_id() { return (unsigned)__builtin_amdgcn_s_getreg((3 << 11) | 20) & 0xFu; }
#define XB_SPIN(cond, bar) do { unsigned _sp = 0; while (cond) { __builtin_amdgcn_s_sleep(1); \
    if ((++_sp & 255u) == 0u) { if (xb_ld(&(bar)[XB_TMO])) break; if (_sp > XB_SPIN_CAP) { atomicAdd(&(bar)[XB_TMO], 1u); break; } } } } while (0)

struct XcdBarrier {
    unsigned* bar; unsigned x;
    volatile LAS unsigned* st;
};

__device__ __forceinline__ XcdBarrier xcd_barrier_post(unsigned* bar, volatile LAS unsigned* st) {
    XcdBarrier b; b.bar = bar; b.x = xb_xcc_id(); b.st = st;
    if (threadIdx.x == 0) (void)xb_add(&bar[XB_XCNT(b.x)], 1u);
    return b;
}
__device__ __forceinline__ void xcd_barrier_complete(unsigned* bar, unsigned x, unsigned& nloc, unsigned& nx) {
    const unsigned G = gridDim.x * gridDim.y * gridDim.z;
    unsigned sum, cnt, mine, sp = 0u;
    for (;;) {
        sum = 0u; cnt = 0u; mine = 0u;
#pragma unroll
        for (unsigned j = 0; j < 16; ++j) { const unsigned c = xb_ld(&bar[XB_XCNT(j)]); sum += c; cnt += (c > 0u) ? 1u : 0u; mine = (j == x) ? c : mine; }
        if (sum == G) break;
        __builtin_amdgcn_s_sleep(1);
        if ((++sp & 255u) == 0u) { if (xb_ld(&bar[XB_TMO])) break; if (sp > XB_SPIN_CAP) { atomicAdd(&bar[XB_TMO], 1u); break; } }
    }
    nloc = mine > 0u ? mine : 1u; nx = cnt > 0u ? cnt : 1u;
}

__device__ __forceinline__ void xcd_barrier(const XcdBarrier& b) {
    asm volatile("s_waitcnt vmcnt(0)" ::: "memory");
    __syncthreads();
    if (threadIdx.x == 0) {
        unsigned* bar = b.bar;
        __builtin_amdgcn_s_waitcnt(0);
        unsigned nloc = b.st[0], nx = b.st[1];
        if (nloc == 0u) { xcd_barrier_complete(bar, b.x, nloc, nx); b.st[0] = nloc; b.st[1] = nx; }
        const unsigned old = xb_add(&bar[XB_XSUB(b.x)], 1u);
        const unsigned gen = old / nloc;
        if (old + 1u == (gen + 1u) * nloc) {
            __builtin_amdgcn_fence(__ATOMIC_RELEASE, "agent");
            asm volatile("s_waitcnt vmcnt(0)" ::: "memory");
            const unsigned og = xb_add(&bar[XB_TOP], 1u);
            const unsigned tg = og / nx;
            if (og + 1u == (tg + 1u) * nx) xb_add(&bar[XB_TOPGEN], 1u);
            else XB_SPIN(xb_ld(&bar[XB_TOPGEN]) == tg, bar);
            __builtin_amdgcn_fence(__ATOMIC_ACQUIRE, "agent");
            xb_add(&bar[XB_XGEN(b.x)], 1u);
            asm volatile("s_waitcnt vmcnt(0)" ::: "memory");
        } else {
            XB_SPIN(xb_ld(&bar[XB_XGEN(b.x)]) == gen, bar);
            __builtin_amdgcn_fence(__ATOMIC_ACQUIRE, "agent");
            asm volatile("s_waitcnt vmcnt(0)" ::: "memory");
        }
    }
    __syncthreads();
}

constexpr size_t WS_BAR = WS_END;
constexpr int MISC_OFF = 131072 + 512;
#define CONVERT_ITEMS(Lc, it0, it1, gwx, ngwx) do { \
        bf16* wlc = (bf16*)(ws + (size_t)(Lc) * LW); const size_t oF = (size_t)(Lc) * D * FF, oS = (size_t)(Lc) * D * D; \
        for (int it = (it0) + (gwx); it < (it1); it += (ngwx)) { \
            int r = it; \
            if (r < I_F) { tr_item(KA->in[3] + oF, D, FF, (bf16*)((unsigned char*)wlc + OW_GU1), 1, KA->in[2] + (Lc) * D, scr, r, lane); continue; } r -= I_F; \
            if (r < I_F) { tr_item(KA->in[4] + oF, D, FF, (bf16*)((unsigned char*)wlc + OW_GU1), 2, KA->in[2] + (Lc) * D, scr, r, lane); continue; } r -= I_F; \
            if (r < I_F) { tr_item(KA->in[5] + oF, FF, D, (bf16*)((unsigned char*)wlc + OW_D1), 0, nullptr, scr, r, lane); continue; } r -= I_F; \
            if (r < I_IN) { tr_item(KA->in[7] + (size_t)(Lc) * D * NIN, D, NIN, (bf16*)((unsigned char*)wlc + OW_IN), 3, KA->in[6] + (Lc) * D, scr, r, lane); continue; } r -= I_IN; \
            if (r < I_SQ) { tr_item(KA->in[18] + oS, D, D, (bf16*)((unsigned char*)wlc + OW_OUT), 0, nullptr, scr, r, lane); continue; } r -= I_SQ; \
            if (r < I_F) { tr_item(KA->in[20] + oF, D, FF, (bf16*)((unsigned char*)wlc + OW_GU2), 1, KA->in[19] + (Lc) * D, scr, r, lane); continue; } r -= I_F; \
            if (r < I_F) { tr_item(KA->in[21] + oF, D, FF, (bf16*)((unsigned char*)wlc + OW_GU2), 2, KA->in[19] + (Lc) * D, scr, r, lane); continue; } r -= I_F; \
            if (r < I_F) { tr_item(KA->in[22] + oF, FF, D, (bf16*)((unsigned char*)wlc + OW_D2), 0, nullptr, scr, r, lane); continue; } r -= I_F; \
            if (r < I_SQ) { tr_item(KA->in[24] + oS, D, D, (bf16*)((unsigned char*)wlc + OW_PG), 0, KA->in[23] + (Lc) * D, scr, r, lane); continue; } r -= I_SQ; \
            tr_item(KA->in[25] + (size_t)(Lc) * DPLE * D, DPLE, D, (bf16*)((unsigned char*)wlc + OW_PP), 0, nullptr, scr, r, lane); \
        } } while (0)
constexpr int I_F = 1408, I_IN = 1536, I_SQ = 512, I_PP = 128;
constexpr int ITEMS = 6 * I_F + I_IN + 2 * I_SQ + I_PP;
constexpr int ITEMS_GU1 = 2 * I_F;
constexpr int ITEMS_SPLIT = 7424;
struct Args { const float* in[26]; float* out; unsigned char* ws; unsigned mask; unsigned pad; };
typedef const __attribute__((address_space(4))) Args* KP;
#define KARGS() ((KP)__builtin_amdgcn_kernarg_segment_ptr())
#define PH_BEGIN KP KA = KARGS(); int Ll = L, Gl = G, bxl = bx, tidl = threadIdx.x; asm volatile("" : "+s"(KA), "+s"(Ll), "+s"(Gl), "+s"(bxl), "+v"(tidl)); unsigned char* ws = KA->ws; float* X = KA->out; \
    const int lane = tidl & 63, wave = __builtin_amdgcn_readfirstlane(tidl >> 6), vcu = (Gl % 8 == 0) ? (bxl % 8) * (Gl / 8) + bxl / 8 : bxl, gw = vcu * NWAVES + wave, NGW = Gl * NWAVES; (void)lane; (void)gw; (void)NGW; \
    const unsigned char* wl = ws + (size_t)Ll * LW; (void)wl; (void)Gl; (void)bxl; (void)X;
#define WPTR(off) ((const bf16*)(wl + (off)))
#define XB ((bf16*)(ws + WS_XB))
#define XB4 ((bf16*)(ws))
#define SSA ((float*)(ws + WS_SSA))
#define SSB ((float*)(ws + WS_SSB))
#define A2 ((bf16*)(ws + WS_A2))
#define Z ((bf16*)(ws + WS_Z))
#define PB ((bf16*)(ws + WS_PB))
#define Hb Z


__global__ void __launch_bounds__(NWAVES * 64, 2) fwd_mega(Args a) {
    extern __shared__ __attribute__((aligned(16))) unsigned char lds_raw[];
    LAS unsigned char* lds = (LAS unsigned char*)lds_raw;
    cg::grid_group grid = cg::this_grid();
    const int G = gridDim.x, bx = blockIdx.x;
    if (threadIdx.x < 2) ((volatile LAS unsigned*)(lds + MISC_OFF))[threadIdx.x] = 0u;
    if (threadIdx.x == 0) (void)xb_add((unsigned*)(KARGS()->ws + WS_BAR) + XB_XCNT(xb_xcc_id()), 1u);
#define GRID_BAR() do { XcdBarrier b_; b_.bar = (unsigned*)(KARGS()->ws + WS_BAR); b_.x = xb_xcc_id(); b_.st = (volatile LAS unsigned*)(lds + MISC_OFF); xcd_barrier(b_); } while (0)

#ifndef REP_P0
#define REP_P0 1
#endif
#ifndef REP_S1
#define REP_S1 1
#endif
#ifndef REP_S2
#define REP_S2 1
#endif
#ifndef REP_S3
#define REP_S3 1
#endif
#ifndef REP_S5
#define REP_S5 1
#endif
#ifndef REP_S8
#define REP_S8 1
#endif
    for (int rep = 0; rep < REP_P0; ++rep)
    if ((PHMASK & 1) && (KARGS()->mask & 1u)) {
        const int L = 0; PH_BEGIN (void)Ll;
        LAS float* scr = (LAS float*)(lds + wave * 16384);
        CONVERT_ITEMS(0, 0, ITEMS_GU1, gw, NGW);
        if (Gl != 256) { CONVERT_ITEMS(0, ITEMS_GU1, ITEMS, gw, NGW); CONVERT_ITEMS(1, 0, ITEMS, gw, NGW); }
        const float* xin = KA->in[0];
        for (int row = gw; row < M; row += NGW) {
            const f32x4* xr = (const f32x4*)(xin + (size_t)row * D) + lane;
            f32x4 v[4]; float s = 0.f;
#pragma unroll
            for (int j = 0; j < 4; ++j) { v[j] = xr[64 * j]; s += (v[j][0] * v[j][0] + v[j][1] * v[j][1]) + (v[j][2] * v[j][2] + v[j][3] * v[j][3]); }
            s = wave_sum(s);
            unsigned long long* o8 = (unsigned long long*)(XB + (size_t)row * D) + lane;
#pragma unroll
            for (int j = 0; j < 4; ++j) o8[64 * j] = (unsigned long long)pk2(v[j][0], v[j][1]) | ((unsigned long long)pk2(v[j][2], v[j][3]) << 32);
            if (lane < 16) SSB[(size_t)row * 16 + lane] = (lane == 0) ? s : 0.f;
        }
        const float* pin = KA->in[1];
        for (size_t i = (size_t)(bxl * (NWAVES * 64) + tidl) * 8; i < (size_t)DEPTH * M * DPLE; i += (size_t)Gl * NWAVES * 64 * 8) {
            const f32x4 v0 = *(const f32x4*)(pin + i), v1 = *(const f32x4*)(pin + i + 4);
            v4u o; o.x = pk2(v0[0], v0[1]); o.y = pk2(v0[2], v0[3]); o.z = pk2(v1[0], v1[1]); o.w = pk2(v1[2], v1[3]);
            *(v4u*)(PB + i) = o;
        }
    }
    GRID_BAR();
    if (KARGS()->mask == 0xC0FFEE11u) grid.sync();

#pragma unroll 1
    for (int L = 0; L < DEPTH; ++L) {
        for (int rep = 0; rep < REP_S1; ++rep)
        if ((PHMASK & 2) && (KARGS()->mask & 2u)) { PH_BEGIN pg8::Gemm g{Ll == 0 ? XB : XB4, WPTR(OW_GU1), M, 2 * FF, D}; pg8::StaticOrder S; S.init(M, 2 * FF, Gl, bxl); pg8::EpiSwiglu E{Hb, SSB};
          pg8::gemm_phase<pg8::EpiSwiglu, pg8::StaticOrder, true, true>(lds, g, S, E);
          if (Gl == 256 && bxl >= 128) { LAS float* scr = (LAS float*)(lds + wave * 16384); CONVERT_ITEMS(Ll, ITEMS_GU1, ITEMS, (bxl - 128) * NWAVES + wave, 128 * NWAVES); } }
        GRID_BAR();
        for (int rep = 0; rep < REP_S2; ++rep)
        if ((PHMASK & 4) && (KARGS()->mask & 4u)) { PH_BEGIN pg8::Gemm g{Hb, WPTR(OW_D1), M, D, FF}; pg8::StaticOrder S; S.init(M, D, Gl, bxl); pg8::EpiResid E{(Ll == 0 && rep == 0) ? KA->in[0] : X, X, XB, SSA, rep == 0 ? 0.5f : 0.0f};
          pg8::gemm_phase<pg8::EpiResid, pg8::StaticOrder, true, true>(lds, g, S, E); }
        GRID_BAR();
        for (int rep = 0; rep < REP_S3; ++rep)
        if ((PHMASK & 8) && (KARGS()->mask & 8u)) { PH_BEGIN pg8::Gemm g{XB, WPTR(OW_IN), M, NIN, D}; pg8::StaticOrder S; S.init(M, NIN, Gl, bxl); pg8::EpiWin E{Z, SSA, KA->in[8] + Ll * 64, KA->in[9] + Ll * 64};
          pg8::gemm_phase<pg8::EpiWin, pg8::StaticOrder, true, true>(lds, g, S, E); }
        GRID_BAR();
        if ((PHMASK & 16) && (KARGS()->mask & 16u)) {
            PH_BEGIN
            att::conv_phase(Z, A2, KA->in[15] + Ll * 3 * 512, KA->in[16] + Ll * 512, KA->in[17] + Ll * 512, gw, NGW, lane);
            const float lam_init = (Ll == 0) ? 0.2f : (0.8f - 0.6f * 0.7408182206817179f);
            const float d1 = wave_sum(KA->in[10][Ll * 64 + lane] * KA->in[11][Ll * 64 + lane]);
            const float d2 = wave_sum(KA->in[12][Ll * 64 + lane] * KA->in[13][Ll * 64 + lane]);
            const float lam = __expf(d1) - __expf(d2) + lam_init;
            const float mq = wave_max(fabsf(KA->in[8][Ll * 64 + lane])), mk = wave_max(fabsf(KA->in[9][Ll * 64 + lane]));
            const float negM = -(64.0f * pg8::QSCALE * mq * mk);
#ifndef REP_ATT
#define REP_ATT 1
#endif
            for (int rep = 0; rep < REP_ATT; ++rep)
            for (int j = vcu; j < 256; j += Gl) {
                const int h = j >> 6, s = j & 63;
#pragma unroll 1
                for (int k2 = 0; k2 < 2; ++k2) att::attn_unit(lds, Z, A2, h, k2 == 0 ? 127 - s : s, negM, lam, KA->in[14] + Ll * 128, 1.0f - lam_init);
            }
        }
        GRID_BAR();
        for (int rep = 0; rep < REP_S5; ++rep)
        if ((PHMASK & 32) && (KARGS()->mask & 32u)) { PH_BEGIN pg8::Gemm g{A2, WPTR(OW_OUT), M, D, D}; pg8::StaticOrder S; S.init(M, D, Gl, bxl); pg8::EpiResid E{X, X, XB, SSB, rep == 0 ? 1.0f : 0.0f};
          pg8::gemm_phase<pg8::EpiResid, pg8::StaticOrder, true, true>(lds, g, S, E); }
        GRID_BAR();
        if ((PHMASK & 64) && (KARGS()->mask & 64u)) { PH_BEGIN pg8::Gemm g{XB, WPTR(OW_GU2), M, 2 * FF, D}; pg8::StaticOrder S; S.init(M, 2 * FF, Gl, bxl); pg8::EpiSwiglu E{Hb, SSB};
          pg8::gemm_phase<pg8::EpiSwiglu, pg8::StaticOrder, true, true>(lds, g, S, E); }
        if ((PHMASK & 128) && (KARGS()->mask & 128u)) { PH_BEGIN int Kp = DPLE; asm volatile("" : "+s"(Kp)); pg8::Gemm g{PB + (size_t)Ll * M * DPLE, WPTR(OW_PP), M, D, Kp}; pg8::StaticOrder S; const bool half_ = (Gl == 256); S.init(M, D, half_ ? 128 : Gl, half_ ? (bxl >= 128 ? bxl - 128 : 1 << 20) : bxl); pg8::EpiPlain E{A2};
          pg8::gemm_phase<pg8::EpiPlain, pg8::StaticOrder, true, true>(lds, g, S, E);
          if (Ll + 1 < DEPTH && Gl == 256 && bxl >= 128) { LAS float* scr = (LAS float*)(lds + wave * 16384); CONVERT_ITEMS(Ll + 1, 0, ITEMS_GU1, (bxl - 128) * NWAVES + wave, 128 * NWAVES); } }
        GRID_BAR();
        if ((PHMASK & 256) && (KARGS()->mask & 256u)) { PH_BEGIN pg8::Gemm g{Hb, WPTR(OW_D2), M, D, FF}; pg8::StaticOrder S; S.init(M, D, Gl, bxl); pg8::EpiResid E{X, X, XB, SSA, 0.5f};
          pg8::gemm_phase<pg8::EpiResid, pg8::StaticOrder, true, true>(lds, g, S, E); }
        GRID_BAR();
        for (int rep = 0; rep < REP_S8; ++rep)
        if ((PHMASK & 512) && (KARGS()->mask & 512u)) { PH_BEGIN pg8::Gemm g{XB, WPTR(OW_PG), M, D, D}; pg8::StaticOrder S; S.init(M, D, Gl, bxl); pg8::EpiPle E{X, XB4, SSA, SSB, A2, rep == 0 ? 1.0f : 0.0f, Ll + 1 < DEPTH};
          pg8::gemm_phase<pg8::EpiPle, pg8::StaticOrder, true, true>(lds, g, S, E); }
        if (L + 1 < DEPTH) GRID_BAR();
    }
}

extern "C" void kernel_launch(void* const* d_in, const int* in_sizes, int n_in, void* d_out, int out_size, void* d_ws, size_t ws_size, hipStream_t stream) {
    static int grid = 0;
    if (grid == 0) {
        if (n_in != 26 || out_size != M * D || ws_size < WS_END + 16384) { fprintf(stderr, "kernel_launch: unexpected shapes (n_in %d, out %d, ws %zu < %zu)\n", n_in, out_size, ws_size, (size_t)WS_END); grid = -1; return; }
        int dev = 0, cus = 0, per_cu = 0;
        hipGetDevice(&dev);
        hipDeviceGetAttribute(&cus, hipDeviceAttributeMultiprocessorCount, dev);
        if (hipFuncSetAttribute((const void*)fwd_mega, hipFuncAttributeMaxDynamicSharedMemorySize, LDS_BYTES) != hipSuccess) { fprintf(stderr, "kernel_launch: hipFuncSetAttribute failed\n"); grid = -1; return; }
        if (hipOccupancyMaxActiveBlocksPerMultiprocessor(&per_cu, (const void*)fwd_mega, NWAVES * 64, LDS_BYTES) != hipSuccess || per_cu < 1) { fprintf(stderr, "kernel_launch: occupancy query gave %d\n", per_cu); per_cu = 1; }
        (void)hipGetLastError();
        grid = cus;
    }
    if (grid < 0) return;
    Args a{};
    for (int i = 0; i < 26; ++i) a.in[i] = (const float*)d_in[i];
    a.out = (float*)d_out; a.ws = (unsigned char*)d_ws; a.mask = RUNMASK; a.pad = 0;
    void* args[] = {&a};
    if (hipMemsetAsync((char*)d_ws + WS_BAR, 0, 16384, stream) != hipSuccess) { fprintf(stderr, "kernel_launch: hipMemsetAsync of the barrier words failed\n"); return; }
    hipError_t e = hipLaunchCooperativeKernel((const void*)fwd_mega, dim3(grid), dim3(NWAVES * 64), args, LDS_BYTES, stream);
    if (e != hipSuccess) fprintf(stderr, "kernel_launch: cooperative launch failed: %s (grid %d)\n", hipGetErrorString(e), grid);
}
```

```cpp
#include <hip/hip_runtime.h>
#include <hip/hip_cooperative_groups.h>
#include <cstdio>
#include <cstdint>
namespace cg = cooperative_groups;
namespace pg8 {
#define PG8_LAS __attribute__((address_space(3)))
typedef unsigned short bf16_t;
typedef short bf16x8 __attribute__((ext_vector_type(8)));
typedef float f32x4 __attribute__((ext_vector_type(4)));
typedef unsigned u32x4 __attribute__((ext_vector_type(4)));
constexpr int BM = 256, BK = 64, HALF = 128, HTB = HALF * BK * 2  , STAGE_BYTES = 8 * HTB, NXCD = 8, WGM = 8;

__host__ __device__ __forceinline__ int lds_byte(int r, int c) { const int st = (r >> 4) * 2 + (c >> 5), rr = r & 15, cc = c & 31, ob = rr * 64 + cc * 2; return st * 1024 + (ob ^ (((ob >> 9) & 1) << 5)); }
__host__ __device__ __forceinline__ void stage_rc(int b, int& R, int& C) { const int st = b / 1024, sb = b % 1024, swz = sb ^ (((sb >> 9) & 1) << 5); R = (st >> 1) * 16 + swz / 64; C = (st & 1) * 32 + (swz % 64) / 2; }
__host__ __device__ __forceinline__ int perm32(int rho) { const int n = rho >> 4, i = rho & 15; return 8 * (i >> 2) + 4 * n + (i & 3); }

struct Unit { int pm, pn; };
struct Gemm { const bf16_t* A; const bf16_t* Bt; int M, N, K; };

struct StaticOrder {
    int nM, nN, nwg, G, c;
    __host__ __device__ void init(int M, int N, int G_, int c_) { nM = M / BM; nN = N / BM; nwg = nM * nN; G = G_; c = c_; }
    __host__ __device__ bool next(int i, Unit& u) const {
        const long L = (long)i * G + c; if (L >= nwg) return false;
        int wgid = (int)L; { const int q = nwg / NXCD, r = nwg % NXCD, xcd = wgid % NXCD, off = wgid / NXCD; wgid = (xcd < r ? xcd * (q + 1) : r * (q + 1) + (xcd - r) * q) + off; }
        const int nig = WGM * nN, gid = wgid / nig, fm = gid * WGM, gsz = (nM - fm) < WGM ? (nM - fm) : WGM;
        u.pm = fm + ((wgid % nig) % gsz); u.pn = (wgid % nig) / gsz; return true;
    }
    __device__ __forceinline__ void a_ready(const Unit&) const {}
    __device__ __forceinline__ void done(const Unit&) const {}
};

__device__ __forceinline__ unsigned cvt_pk_bf16(float lo, float hi) { unsigned r; asm volatile("v_cvt_pk_bf16_f32 %0, %1, %2" : "=v"(r) : "v"(lo), "v"(hi)); return r; }
typedef float f32x2 __attribute__((ext_vector_type(2)));

typedef unsigned u32x4_t __attribute__((ext_vector_type(4)));
constexpr float RMS_EPS = 1e-6f;
constexpr float LOG2E = 1.4426950408889634f;
constexpr float QSCALE = 0.125f * LOG2E;
constexpr int DM = 1024, DFF = 2816, DIN = 3072;

__device__ __forceinline__ float row_rstd(const float* ss, int row) {
    const f32x4* p = (const f32x4*)(ss + (size_t)row * 16);
    const f32x4 a = p[0], b = p[1], c = p[2], d = p[3];
    const float s = ((a[0] + a[1]) + (a[2] + a[3])) + ((b[0] + b[1]) + (b[2] + b[3])) + ((c[0] + c[1]) + (c[2] + c[3])) + ((d[0] + d[1]) + (d[2] + d[3]));
    return __builtin_amdgcn_rsqf(s * (1.0f / DM) + RMS_EPS);
}
__device__ __forceinline__ void rows_rstd(const float* ss, int row0, int fq, float (&rs)[2][4]) {
    f32x4 q[2][4];
#pragma unroll
    for (int ai = 0; ai < 2; ++ai)
#pragma unroll
        for (int m = 0; m < 4; ++m) q[ai][m] = *(const f32x4*)(ss + (size_t)(row0 + ai * HALF + m * 16) * 16 + 4 * fq);
#pragma unroll
    for (int ai = 0; ai < 2; ++ai)
#pragma unroll
        for (int m = 0; m < 4; ++m) { float t = (q[ai][m][0] + q[ai][m][1]) + (q[ai][m][2] + q[ai][m][3]); t += __shfl_xor(t, 16); t += __shfl_xor(t, 32); rs[ai][m] = __builtin_amdgcn_rsqf(t * (1.0f / DM) + RMS_EPS); }
}
__device__ __forceinline__ float sigmoidf_fast(float a) { return __builtin_amdgcn_rcpf(1.0f + __builtin_amdgcn_exp2f(-a * LOG2E)); }
__device__ __forceinline__ u32x4_t pack8(const f32x4 v0, const f32x4 v1) {
    u32x4_t w; w.x = cvt_pk_bf16(v0[0], v0[1]); w.y = cvt_pk_bf16(v0[2], v0[3]); w.z = cvt_pk_bf16(v1[0], v1[1]); w.w = cvt_pk_bf16(v1[2], v1[3]); return w;
}
__device__ __forceinline__ float bf_lo(unsigned w) { return __uint_as_float(w << 16); }
__device__ __forceinline__ float bf_hi(unsigned w) { return __uint_as_float(w & 0xffff0000u); }

struct EpiSwiglu {
    static constexpr bool PERM = true, AFTER_DRAIN = false;
    bf16_t* H; const float* ss;
    __device__ __forceinline__ void operator()(const f32x4 (&acc)[2][2][4][2], const Unit& u, int wr, int wc, int fr, int fq) const {
        const int hcol = u.pn * 128 + wc * 32 + 8 * fq;
        float rsv[2][4]; rows_rstd(ss, u.pm * BM + wr * 64 + fr, fq, rsv);
#pragma unroll
        for (int ai = 0; ai < 2; ++ai)
#pragma unroll
            for (int m = 0; m < 4; ++m) {
                const int row = u.pm * BM + ai * HALF + wr * 64 + m * 16 + fr;
                const float rs = rsv[ai][m];
                const float k1 = -rs * LOG2E, k2 = rs * rs;
                f32x2 g[4], up[4], e[4], r[4];
#pragma unroll
                for (int p = 0; p < 4; ++p) { g[p] = (f32x2){acc[ai][0][m][p >> 1][2 * (p & 1)], acc[ai][0][m][p >> 1][2 * (p & 1) + 1]}; up[p] = (f32x2){acc[ai][1][m][p >> 1][2 * (p & 1)], acc[ai][1][m][p >> 1][2 * (p & 1) + 1]}; }
#pragma unroll
                for (int p = 0; p < 4; ++p) { const f32x2 t = g[p] * k1; e[p].x = __builtin_amdgcn_exp2f(t.x); e[p].y = __builtin_amdgcn_exp2f(t.y); }
#pragma unroll
                for (int p = 0; p < 4; ++p) { const f32x2 d = e[p] + 1.0f; r[p].x = __builtin_amdgcn_rcpf(d.x); r[p].y = __builtin_amdgcn_rcpf(d.y); }
                f32x4 o[2];
#pragma unroll
                for (int p = 0; p < 4; ++p) { const f32x2 v = (g[p] * up[p]) * (r[p] * k2); o[p >> 1][2 * (p & 1)] = v.x; o[p >> 1][2 * (p & 1) + 1] = v.y; }
                *(u32x4_t*)(H + (size_t)row * DFF + hcol) = pack8(o[0], o[1]);
            }
    }
};

struct EpiResid {
    static constexpr bool PERM = true, AFTER_DRAIN = false;
    const float* xin; float* xout; bf16_t* xb; float* ssw; float coef;
    __device__ __forceinline__ void operator()(const f32x4 (&acc)[2][2][4][2], const Unit& u, int wr, int wc, int fr, int fq) const {
        const size_t colb = (size_t)u.pn * BM + wc * 32 + 8 * fq;
        const int rowb = u.pm * BM + wr * 64 + fr;
        f32x4 a[2][2][2][2];
        float sqv[8];
#define RES_LOAD(buf, b) do { _Pragma("unroll") for (int mm_ = 0; mm_ < 2; ++mm_) _Pragma("unroll") for (int bj_ = 0; bj_ < 2; ++bj_) { \
            const size_t off_ = (size_t)(rowb + ((b) >> 1) * HALF + (2 * ((b) & 1) + mm_) * 16) * DM + colb + bj_ * HALF; \
            a[buf][mm_][bj_][0] = *(const f32x4*)(xin + off_); a[buf][mm_][bj_][1] = *(const f32x4*)(xin + off_ + 4); } } while (0)
#define RES_STORE(buf, b) do { _Pragma("unroll") for (int mm_ = 0; mm_ < 2; ++mm_) { const int ai_ = (b) >> 1, m_ = 2 * ((b) & 1) + mm_; const int row_ = rowb + ai_ * HALF + m_ * 16; float sq_ = 0.f; \
            _Pragma("unroll") for (int bj_ = 0; bj_ < 2; ++bj_) { const size_t off_ = (size_t)row_ * DM + colb + bj_ * HALF; \
                const f32x4 v0_ = a[buf][mm_][bj_][0] + acc[ai_][bj_][m_][0] * coef, v1_ = a[buf][mm_][bj_][1] + acc[ai_][bj_][m_][1] * coef; \
                *(f32x4*)(xout + off_) = v0_; *(f32x4*)(xout + off_ + 4) = v1_; *(u32x4_t*)(xb + off_) = pack8(v0_, v1_); \
                sq_ += (v0_[0] * v0_[0] + v0_[1] * v0_[1]) + (v0_[2] * v0_[2] + v0_[3] * v0_[3]) + (v1_[0] * v1_[0] + v1_[1] * v1_[1]) + (v1_[2] * v1_[2] + v1_[3] * v1_[3]); } \
            sqv[2 * (b) + mm_] = sq_; } } while (0)
#define RES_FENCE() asm volatile("" ::: "memory")
        RES_LOAD(0, 0); RES_LOAD(1, 1); RES_FENCE();
        RES_STORE(0, 0); RES_FENCE(); RES_LOAD(0, 2); RES_FENCE();
        RES_STORE(1, 1); RES_FENCE(); RES_LOAD(1, 3); RES_FENCE();
        RES_STORE(0, 2); RES_FENCE();
        RES_STORE(1, 3);
#pragma unroll
        for (int i = 0; i < 8; ++i) sqv[i] += __shfl_xor(sqv[i], 16);
#pragma unroll
        for (int i = 0; i < 8; ++i) sqv[i] += __shfl_xor(sqv[i], 32);
        if (fq == 0) {
#pragma unroll
            for (int i = 0; i < 8; ++i) ssw[(size_t)(rowb + (i >> 2) * HALF + (i & 3) * 16) * 16 + u.pn * 4 + wc] = sqv[i];
        }
#undef RES_LOAD
#undef RES_STORE
#undef RES_FENCE
    }
};

struct EpiWin {
    static constexpr bool PERM = true, AFTER_DRAIN = false;
    bf16_t* Z; const float* ss; const float* qg; const float* kg;
    __device__ __forceinline__ void operator()(const f32x4 (&acc)[2][2][4][2], const Unit& u, int wr, int wc, int fr, int fq) const {
        const bool isqk = u.pn < 4; const bool isq = u.pn < 2;
        float rsv[2][4]; rows_rstd(ss, u.pm * BM + wr * 64 + fr, fq, rsv);
        f32x4 gn[2][2];
#pragma unroll
        for (int bj = 0; bj < 2; ++bj)
#pragma unroll
            for (int n = 0; n < 2; ++n) {
                if (isqk) { const float* gp = (isq ? qg : kg) + 32 * bj + 8 * fq + 4 * n; gn[bj][n] = *(const f32x4*)gp; if (isq) gn[bj][n] = gn[bj][n] * QSCALE; }
                else gn[bj][n] = (f32x4){1.f, 1.f, 1.f, 1.f};
            }
#pragma unroll
        for (int ai = 0; ai < 2; ++ai)
#pragma unroll
            for (int m = 0; m < 4; ++m) {
                const int row = u.pm * BM + ai * HALF + wr * 64 + m * 16 + fr;
                const float rs = rsv[ai][m];
                f32x4 v[2][2]; float sq = 0.f;
#pragma unroll
                for (int bj = 0; bj < 2; ++bj)
#pragma unroll
                    for (int n = 0; n < 2; ++n) { v[bj][n] = acc[ai][bj][m][n] * rs; const f32x4 t = v[bj][n]; sq += (t[0] * t[0] + t[1] * t[1]) + (t[2] * t[2] + t[3] * t[3]); }
                float rn = 1.f;
                if (isqk) { sq += __shfl_xor(sq, 16); sq += __shfl_xor(sq, 32); rn = __builtin_amdgcn_rsqf(sq * (1.0f / 64.0f) + RMS_EPS); }
#pragma unroll
                for (int bj = 0; bj < 2; ++bj) {
                    const f32x4 o0 = v[bj][0] * rn * gn[bj][0], o1 = v[bj][1] * rn * gn[bj][1];
                    *(u32x4_t*)(Z + (size_t)row * DIN + u.pn * BM + 64 * wc + 32 * bj + 8 * fq) = pack8(o0, o1);
                }
            }
    }
};

struct EpiPlain {
    static constexpr bool PERM = true, AFTER_DRAIN = false;
    bf16_t* O;
    __device__ __forceinline__ void operator()(const f32x4 (&acc)[2][2][4][2], const Unit& u, int wr, int wc, int fr, int fq) const {
#pragma unroll
        for (int ai = 0; ai < 2; ++ai)
#pragma unroll
            for (int m = 0; m < 4; ++m) {
                const int row = u.pm * BM + ai * HALF + wr * 64 + m * 16 + fr;
#pragma unroll
                for (int bj = 0; bj < 2; ++bj)
                    *(u32x4_t*)(O + (size_t)row * DM + u.pn * BM + bj * HALF + wc * 32 + 8 * fq) = pack8(acc[ai][bj][m][0], acc[ai][bj][m][1]);
            }
    }
};

struct EpiPle {
    static constexpr bool PERM = true, AFTER_DRAIN = false;
    float* x; bf16_t* xb; const float* ssr; float* ssw; const bf16_t* pp; float coef; bool aux;
    __device__ __forceinline__ void operator()(const f32x4 (&acc)[2][2][4][2], const Unit& u, int wr, int wc, int fr, int fq) const {
        float rsv[2][4]; rows_rstd(ssr, u.pm * BM + wr * 64 + fr, fq, rsv);
        float sqv[8];
        const size_t colb = (size_t)u.pn * BM + wc * 32 + 8 * fq;
#pragma unroll
        for (int ai = 0; ai < 2; ++ai)
#pragma unroll
            for (int m = 0; m < 4; ++m) {
                const int row = u.pm * BM + ai * HALF + wr * 64 + m * 16 + fr;
                const size_t off0 = (size_t)row * DM + colb;
                f32x4 a[2][2]; u32x4_t pw[2];
#pragma unroll
                for (int bj = 0; bj < 2; ++bj) { a[bj][0] = *(const f32x4*)(x + off0 + bj * HALF); a[bj][1] = *(const f32x4*)(x + off0 + bj * HALF + 4); pw[bj] = *(const u32x4_t*)(pp + off0 + bj * HALF); }
                asm volatile("" ::: "memory");
                const float rs = rsv[ai][m];
                float sq = 0.f;
#pragma unroll
                for (int bj = 0; bj < 2; ++bj) {
                    const size_t off = off0 + bj * HALF;
                    const u32x4_t w = pw[bj];
                    const f32x4 p0 = (f32x4){bf_lo(w.x), bf_hi(w.x), bf_lo(w.y), bf_hi(w.y)}, p1 = (f32x4){bf_lo(w.z), bf_hi(w.z), bf_lo(w.w), bf_hi(w.w)};
                    f32x4 v0, v1;
#pragma unroll
                    for (int j = 0; j < 4; ++j) { v0[j] = a[bj][0][j] + coef * sigmoidf_fast(acc[ai][bj][m][0][j] * rs) * p0[j]; v1[j] = a[bj][1][j] + coef * sigmoidf_fast(acc[ai][bj][m][1][j] * rs) * p1[j]; }
                    *(f32x4*)(x + off) = v0; *(f32x4*)(x + off + 4) = v1;
                    if (aux) *(u32x4_t*)(xb + off) = pack8(v0, v1);
                    sq += (v0[0] * v0[0] + v0[1] * v0[1]) + (v0[2] * v0[2] + v0[3] * v0[3]) + (v1[0] * v1[0] + v1[1] * v1[1]) + (v1[2] * v1[2] + v1[3] * v1[3]);
                }
                sqv[4 * ai + m] = sq;
                asm volatile("" ::: "memory");
            }
        if (aux) {
#pragma unroll
            for (int i = 0; i < 8; ++i) sqv[i] += __shfl_xor(sqv[i], 16);
#pragma unroll
            for (int i = 0; i < 8; ++i) sqv[i] += __shfl_xor(sqv[i], 32);
            if (fq == 0) {
#pragma unroll
                for (int i = 0; i < 8; ++i) ssw[(size_t)(u.pm * BM + (i >> 2) * HALF + wr * 64 + (i & 3) * 16 + fr) * 16 + u.pn * 4 + wc] = sqv[i];
            }
        }
    }
};
template <class Epi, class Sched, bool ALIGN_EPI = false, bool SP2 = false>
__device__ __forceinline__ void gemm_phase(PG8_LAS unsigned char* lds, const Gemm g, const Sched& S, const Epi& E) {
    int tid_ = threadIdx.x; asm volatile("" : "+v"(tid_));
    const int tid = tid_, wid = __builtin_amdgcn_readfirstlane(tid >> 6), lane = tid & 63, wr = wid >> 2, wc = wid & 3, fr = lane & 15, fq = lane >> 4;
    const int K = g.K, nt = K / BK;
    unsigned voffA[2], voffB[2];
#pragma unroll
    for (int i = 0; i < 2; ++i) { int R, C; stage_rc(tid * 16 + i * 8192, R, C); const int Rb = Epi::PERM ? ((R & ~31) + perm32(R & 31)) : R;
        voffA[i] = (unsigned)(R * K + C) * 2u; voffB[i] = (unsigned)(Rb * K + C) * 2u; }
    const size_t kstep = (size_t)(BK * 2);
    const size_t hstep = (size_t)HALF * K * 2;
    const size_t tstep = 2 * hstep;
    const unsigned ldsw = (unsigned)wid * 1024u;
    const int aoff = lds_byte(wr * 64 + fr, fq * 8), boff = lds_byte(wc * 32 + fr, fq * 8);
#define PG8_SA(b, h) (((b) * 2 + (h)) * HTB)
#define PG8_SB(b, h) ((4 + (b) * 2 + (h)) * HTB)
#define PG8_STAGE(bufoff, gbase, voff) do { _Pragma("unroll") for (int _i = 0; _i < 2; ++_i) \
        __builtin_amdgcn_global_load_lds((const unsigned*)((const char*)(gbase) + (voff)[_i]), (PG8_LAS unsigned*)(lds + (bufoff) + ldsw + _i * 8192), 16, 0, 0); } while (0)
#define PG8_LDA(dst, b, h) do { _Pragma("unroll") for (int m = 0; m < 4; ++m) _Pragma("unroll") for (int k = 0; k < 2; ++k) dst[m][k] = *(const PG8_LAS bf16x8*)(lds + PG8_SA(b, h) + aoff + m * 2048 + k * 1024); } while (0)
#define PG8_LDB(dst, b, h) do { _Pragma("unroll") for (int n = 0; n < 2; ++n) _Pragma("unroll") for (int k = 0; k < 2; ++k) dst[n][k] = *(const PG8_LAS bf16x8*)(lds + PG8_SB(b, h) + boff + n * 2048 + k * 1024); } while (0)
#define PG8_MMA(ai, bj, At, Bt) do { __builtin_amdgcn_s_setprio(1); _Pragma("unroll") for (int m = 0; m < 4; ++m) _Pragma("unroll") for (int n = 0; n < 2; ++n) _Pragma("unroll") for (int k = 0; k < 2; ++k) \
        acc[ai][bj][m][n] = __builtin_amdgcn_mfma_f32_16x16x32_bf16(Bt[n][k], At[m][k], acc[ai][bj][m][n], 0, 0, 0); __builtin_amdgcn_s_setprio(0); } while (0)
#define PG8_WAIT_V(n) asm volatile("s_waitcnt vmcnt(" #n ")" ::: "memory")
#define PG8_WAIT_L(n) asm volatile("s_waitcnt lgkmcnt(" #n ")" ::: "memory")
#define PG8_BAR __builtin_amdgcn_s_barrier()
#define PG8_SCHED __builtin_amdgcn_sched_barrier(0)
    Unit cur, nxt; int ui = 0;
    if (!S.next(0, cur)) return;
    f32x4 acc[2][2][4][2];
#pragma unroll
    for (int a = 0; a < 2; ++a)
#pragma unroll
        for (int b = 0; b < 2; ++b)
#pragma unroll
            for (int m = 0; m < 4; ++m)
#pragma unroll
                for (int n = 0; n < 2; ++n) acc[a][b][m][n] = (f32x4){0.f, 0.f, 0.f, 0.f};
    bf16x8 At[4][2], B0[2][2], B1[2][2];
    const char* cA = (const char*)g.A + (size_t)cur.pm * tstep; const char* cB = (const char*)g.Bt + (size_t)cur.pn * tstep;
    S.a_ready(cur);
    if constexpr (SP2) {
        PG8_STAGE(PG8_SB(0, 0), cB, voffB); PG8_STAGE(PG8_SB(0, 1), cB + hstep, voffB); PG8_STAGE(PG8_SA(0, 0), cA, voffA); PG8_STAGE(PG8_SA(0, 1), cA + hstep, voffA);
        if (wr == 1) PG8_BAR;
        PG8_WAIT_V(2); PG8_BAR;
        PG8_STAGE(PG8_SB(1, 0), cB + kstep, voffB); PG8_STAGE(PG8_SA(1, 0), cA + kstep, voffA); PG8_STAGE(PG8_SB(1, 1), cB + hstep + kstep, voffB);
        PG8_WAIT_V(6); PG8_BAR;
    } else {
        PG8_STAGE(PG8_SB(0, 0), cB, voffB); PG8_STAGE(PG8_SA(0, 0), cA, voffA); PG8_STAGE(PG8_SB(0, 1), cB + hstep, voffB); PG8_STAGE(PG8_SA(0, 1), cA + hstep, voffA);
        if (wr == 1) PG8_BAR;
        PG8_WAIT_V(4); PG8_BAR;
        PG8_STAGE(PG8_SB(1, 0), cB + kstep, voffB); PG8_STAGE(PG8_SA(1, 0), cA + kstep, voffA); PG8_STAGE(PG8_SB(1, 1), cB + hstep + kstep, voffB);
        PG8_WAIT_V(6); PG8_BAR;
    }
    for (;;) {
        const bool has_next = S.next(ui + 1, nxt);
        const char* nA = has_next ? (const char*)g.A + (size_t)nxt.pm * tstep : cA; const char* nB = has_next ? (const char*)g.Bt + (size_t)nxt.pn * tstep : cB;
        for (int t = 0; t < nt; t += 2) {
            const bool last = (t == nt - 2);
            const char* a1 = cA + (size_t)(t + 1) * kstep;
            const char* a2 = last ? nA : cA + (size_t)(t + 2) * kstep; const char* b2 = last ? nB : cB + (size_t)(t + 2) * kstep;
            const char* a3 = a2 + kstep; const char* b3 = b2 + kstep;
            if (last && has_next) S.a_ready(nxt);
            if constexpr (SP2) {
            PG8_LDB(B0, 0, 0); PG8_LDB(B1, 0, 1); PG8_SCHED; PG8_LDA(At, 0, 0); PG8_STAGE(PG8_SA(1, 1), a1 + hstep, voffA);
            PG8_WAIT_V(8); PG8_WAIT_L(0); PG8_BAR; PG8_MMA(0, 0, At, B0); PG8_MMA(0, 1, At, B1); PG8_BAR; PG8_SCHED;
            PG8_LDA(At, 0, 1); PG8_STAGE(PG8_SB(0, 0), b2, voffB); PG8_STAGE(PG8_SB(0, 1), b2 + hstep, voffB); PG8_STAGE(PG8_SA(0, 0), a2, voffA);
            PG8_WAIT_V(8); PG8_WAIT_L(0); PG8_BAR; PG8_MMA(1, 0, At, B0); PG8_MMA(1, 1, At, B1); PG8_BAR; PG8_SCHED;
            PG8_LDB(B0, 1, 0); PG8_LDB(B1, 1, 1); PG8_SCHED; PG8_LDA(At, 1, 0); PG8_STAGE(PG8_SA(0, 1), a2 + hstep, voffA);
            PG8_WAIT_V(8); PG8_WAIT_L(0); PG8_BAR; PG8_MMA(0, 0, At, B0); PG8_MMA(0, 1, At, B1); PG8_BAR; PG8_SCHED;
            PG8_LDA(At, 1, 1); PG8_STAGE(PG8_SB(1, 0), b3, voffB); PG8_STAGE(PG8_SB(1, 1), b3 + hstep, voffB); PG8_STAGE(PG8_SA(1, 0), a3, voffA);
            PG8_WAIT_V(8); PG8_WAIT_L(0); PG8_BAR; PG8_MMA(1, 0, At, B0); PG8_MMA(1, 1, At, B1); PG8_BAR; PG8_SCHED;
            } else {
            PG8_LDB(B0, 0, 0); PG8_SCHED; PG8_LDA(At, 0, 0); PG8_STAGE(PG8_SA(1, 1), a1 + hstep, voffA);
            PG8_WAIT_L(8); PG8_BAR; PG8_WAIT_L(0); PG8_MMA(0, 0, At, B0); PG8_BAR; PG8_SCHED;
            PG8_LDB(B1, 0, 1); PG8_STAGE(PG8_SB(0, 0), b2, voffB);
            PG8_BAR; PG8_WAIT_L(0); PG8_MMA(0, 1, At, B1); PG8_BAR;
            PG8_LDA(At, 0, 1); PG8_STAGE(PG8_SA(0, 0), a2, voffA);
            PG8_BAR; PG8_WAIT_L(0); PG8_MMA(1, 0, At, B0); PG8_BAR; PG8_SCHED;
            PG8_STAGE(PG8_SB(0, 1), b2 + hstep, voffB);
            PG8_WAIT_V(6); PG8_BAR; PG8_MMA(1, 1, At, B1); PG8_BAR;
            PG8_LDB(B0, 1, 0); PG8_SCHED; PG8_LDA(At, 1, 0); PG8_STAGE(PG8_SA(0, 1), a2 + hstep, voffA);
            PG8_WAIT_L(8); PG8_BAR; PG8_WAIT_L(0); PG8_MMA(0, 0, At, B0); PG8_BAR; PG8_SCHED;
            PG8_LDB(B1, 1, 1); PG8_STAGE(PG8_SB(1, 0), b3, voffB);
            PG8_BAR; PG8_WAIT_L(0); PG8_MMA(0, 1, At, B1); PG8_BAR;
            PG8_LDA(At, 1, 1); PG8_STAGE(PG8_SA(1, 0), a3, voffA);
            PG8_BAR; PG8_WAIT_L(0); PG8_MMA(1, 0, At, B0); PG8_BAR; PG8_SCHED;
            PG8_STAGE(PG8_SB(1, 1), b3 + hstep, voffB);
            PG8_WAIT_V(6); PG8_BAR; PG8_MMA(1, 1, At, B1); PG8_BAR;
            }
        }
        if constexpr (ALIGN_EPI) { if (wr == 0) PG8_BAR; }
        if constexpr (!Epi::AFTER_DRAIN) { E(acc, cur, wr, wc, fr, fq); S.done(cur); }
        if (!has_next) break;
#pragma unroll
        for (int a = 0; a < 2; ++a)
#pragma unroll
            for (int b = 0; b < 2; ++b)
#pragma unroll
                for (int m = 0; m < 4; ++m)
#pragma unroll
                    for (int n = 0; n < 2; ++n) acc[a][b][m][n] = (f32x4){0.f, 0.f, 0.f, 0.f};
        cur = nxt; cA = nA; cB = nB; ++ui;
        if constexpr (ALIGN_EPI) { if (wr == 1) PG8_BAR; }
    }
    PG8_WAIT_V(0);
    if constexpr (!ALIGN_EPI) { if (wr == 0) PG8_BAR; }
    PG8_BAR;
    if constexpr (Epi::AFTER_DRAIN) { E.fused(acc, cur, wr, wc, fr, fq, lds, wid, lane); S.done(cur); }
#undef PG8_SA
#undef PG8_SB
#undef PG8_STAGE
#undef PG8_LDA
#undef PG8_LDB
#undef PG8_MMA
#undef PG8_WAIT_V
#undef PG8_WAIT_L
#undef PG8_BAR
#undef PG8_SCHED
}
}

namespace att {
typedef unsigned short bf16_t;
typedef short bf16x8 __attribute__((ext_vector_type(8)));
typedef short s16x4 __attribute__((ext_vector_type(4)));
typedef short v4i16_t __attribute__((ext_vector_type(4)));
typedef float f32x16 __attribute__((ext_vector_type(16)));
typedef float f32x4 __attribute__((ext_vector_type(4)));
typedef unsigned u32x4 __attribute__((ext_vector_type(4)));
typedef unsigned u32x2 __attribute__((ext_vector_type(2)));
#define ALAS __attribute__((address_space(3)))
constexpr int SEQ = 16384, ZP = 3072, QROWS = 128, NQB = SEQ / QROWS, DMODEL = 1024;
constexpr int STAGE = 32768, XB_OFF = 65536;
constexpr float EPS = 1e-6f;

__device__ __forceinline__ int crow(int r, int hi) { return (r & 3) + 8 * (r >> 2) + 4 * hi; }
typedef float f32x2_t __attribute__((ext_vector_type(2))); typedef __bf16 bf16x2_t __attribute__((ext_vector_type(2)));
__device__ __forceinline__ unsigned cvtpk(float lo, float hi) { f32x2_t v = {lo, hi}; bf16x2_t b = __builtin_convertvector(v, bf16x2_t); return __builtin_bit_cast(unsigned, b); }
__device__ __forceinline__ void glds16(const void* gsrc, unsigned lds_dst) { unsigned keep;
    asm volatile("s_mov_b32 %0, m0\n\ts_mov_b32 m0, %2\n\ts_nop 0\n\tglobal_load_lds_dwordx4 %1, off\n\ts_mov_b32 m0, %0" : "=&s"(keep) : "v"(gsrc), "s"(lds_dst) : "memory"); }
#define ATT_WAIT_BAR(N) asm volatile("s_waitcnt vmcnt(" #N ") lgkmcnt(0)\n\ts_barrier" ::: "memory")
__device__ __forceinline__ s16x4 vtr(const ALAS unsigned char* p) { return __builtin_bit_cast(s16x4, __builtin_amdgcn_ds_read_tr16_b64_v4i16((ALAS v4i16_t*)p)); }

__device__ __forceinline__ void attn_unit(ALAS unsigned char* lds, const bf16_t* __restrict__ z, bf16_t* __restrict__ A2, int h, int qb,
                                          float negM, float lam, const float* __restrict__ ogain, float oscale) {
    int tid_ = threadIdx.x; asm volatile("" : "+v"(tid_));
    const int tid = tid_, lane = tid & 63, wid = __builtin_amdgcn_readfirstlane(tid >> 6), r32 = lane & 31, hi = lane >> 5;
    const int m = wid & 1, g = wid >> 1;
    const int q0 = qb * QROWS, qrow = q0 + 32 * g + r32;
    bf16x8 qf[4];
    { const bf16_t* qp = z + (size_t)qrow * ZP + h * 128 + m * 64 + hi * 8;
#pragma unroll
      for (int d0 = 0; d0 < 4; ++d0) qf[d0] = *(const bf16x8*)(qp + 16 * d0); }
    const int NT = 2 * qb + 2;
    const int tlast = (q0 + 32 * g + 31) >> 6;
    const unsigned lds0 = (unsigned)(uintptr_t)lds;
    const int kkey0 = 16 * (wid & 3) + (lane >> 3);
    const bf16_t* ksrc = z + (size_t)kkey0 * ZP + 512 + h * 128 + (wid >> 2) * 64 + (((lane & 7) ^ ((kkey0 >> 1) & 7)) * 8);
    const bf16_t* ksrc2 = z + (size_t)(kkey0 + 8) * ZP + 512 + h * 128 + (wid >> 2) * 64 + (((lane & 7) ^ (((kkey0 + 8) >> 1) & 7)) * 8);
    const bf16_t* vsrc = z + (size_t)(16 * (wid & 3) + (lane >> 2)) * ZP + 1024 + h * 128 + (2 * (wid >> 2)) * 32 + (lane & 3) * 8;
    const unsigned kdst = lds0 + (wid >> 2) * 8192 + (2 * (wid & 3)) * 1024, vdst = lds0 + 65536 + (2 * (wid >> 2)) * 4096 + (wid & 3) * 1024;
#define ATT_DMAK(t) do { const size_t o_ = (size_t)(t) * 64 * ZP; const unsigned sb_ = (unsigned)((((t) >> 1) & 1) * 32768 + ((t) & 1) * 16384); \
        glds16(ksrc + o_, (unsigned)__builtin_amdgcn_readfirstlane(kdst + sb_)); glds16(ksrc2 + o_, (unsigned)__builtin_amdgcn_readfirstlane(kdst + sb_ + 1024)); } while (0)
#define ATT_DMAV(t) do { const size_t o_ = (size_t)(t) * 64 * ZP; const unsigned sb_ = (unsigned)(((t) & 3) * 16384); \
        glds16(vsrc + o_, (unsigned)__builtin_amdgcn_readfirstlane(vdst + sb_)); glds16(vsrc + o_ + 32, (unsigned)__builtin_amdgcn_readfirstlane(vdst + sb_ + 4096)); } while (0)
    asm volatile("" : "+v"(qf[0]), "+v"(qf[1]), "+v"(qf[2]), "+v"(qf[3]));
    asm volatile("s_waitcnt vmcnt(0)" ::: "memory");
    ATT_DMAK(0); ATT_DMAK(1); ATT_DMAV(0);
    ATT_WAIT_BAR(0);
    f32x16 o[4];
#pragma unroll
    for (int d = 0; d < 4; ++d)
#pragma unroll
        for (int r = 0; r < 16; ++r) o[d][r] = 0.f;
    float l = 0.f;
    const int kfx = (r32 >> 1) & 7;
    const int kro = m * 8192 + r32 * 128;
    const int kq0 = kro + ((0 + hi) ^ kfx) * 16, kq1 = kro + ((2 + hi) ^ kfx) * 16, kq2 = kro + ((4 + hi) ^ kfx) * 16, kq3 = kro + ((6 + hi) ^ kfx) * 16;
    const int vro = 65536 + ((lane >> 4) & 1) * 32 + (lane & 3) * 8 + (4 * hi + ((lane & 15) >> 2)) * 64;
    const f32x16 zero16 = {0.f, 0.f, 0.f, 0.f, 0.f, 0.f, 0.f, 0.f, 0.f, 0.f, 0.f, 0.f, 0.f, 0.f, 0.f, 0.f};
#define ATT_SBAR() __builtin_amdgcn_sched_barrier(0)
#define ATT_PIN(x) asm volatile("" : "+v"(x))
#define ATT_EX(v) __builtin_amdgcn_exp2f(v)
#define ATT_MF(a, b, c) __builtin_amdgcn_mfma_f32_32x32x16_bf16(a, b, c, 0, 0, 0)
#define ATT_VLOAD(arr, db) do { _Pragma("unroll") for (int ks_ = 0; ks_ < 4; ++ks_) { arr[2 * ks_] = vtr(Vb + (db) * 4096 + ks_ * 1024); arr[2 * ks_ + 1] = vtr(Vb + (db) * 4096 + ks_ * 1024 + 512); } } while (0)
#define ATT_VF(arr, ks) (bf16x8){arr[2 * (ks)][0], arr[2 * (ks)][1], arr[2 * (ks)][2], arr[2 * (ks)][3], arr[2 * (ks) + 1][0], arr[2 * (ks) + 1][1], arr[2 * (ks) + 1][2], arr[2 * (ks) + 1][3]}
#define ATT_PWB(PW, ks) __builtin_bit_cast(bf16x8, PW[ks])
#define ATT_QK(t) ATT_QKH(t, do { } while (0), do { } while (0))
#define ATT_QKH(t, HOOK, HOOK2) do { const ALAS unsigned char* Kb = lds + (((t) >> 1) & 1) * 32768 + ((t) & 1) * 16384; bf16x8 kf[4], kg2[4]; \
        kf[0] = *(const ALAS bf16x8*)(Kb + kq0); kf[1] = *(const ALAS bf16x8*)(Kb + kq0 + 4096); kf[2] = *(const ALAS bf16x8*)(Kb + kq1); kf[3] = *(const ALAS bf16x8*)(Kb + kq1 + 4096); \
        kg2[0] = *(const ALAS bf16x8*)(Kb + kq2); kg2[1] = *(const ALAS bf16x8*)(Kb + kq2 + 4096); kg2[2] = *(const ALAS bf16x8*)(Kb + kq3); kg2[3] = *(const ALAS bf16x8*)(Kb + kq3 + 4096); \
        ATT_SBAR(); HOOK; ATT_SBAR(); \
        c0 = ATT_MF(kf[0], qf[0], zero16); c1 = ATT_MF(kf[1], qf[0], zero16); c0 = ATT_MF(kf[2], qf[1], c0); c1 = ATT_MF(kf[3], qf[1], c1); \
        c0 = ATT_MF(kg2[0], qf[2], c0); c1 = ATT_MF(kg2[1], qf[2], c1); c0 = ATT_MF(kg2[2], qf[3], c0); c1 = ATT_MF(kg2[3], qf[3], c1); \
        ATT_SBAR(); HOOK2; ATT_SBAR(); } while (0)
#define ATT_SOFTMAX(PWN, t) do { \
        _Pragma("unroll") for (int r = 0; r < 16; ++r) { c0[r] = ATT_EX(c0[r]); c1[r] = ATT_EX(c1[r]); } \
        if ((t) == tlast) { const int kb_ = 64 * (t) + 4 * hi; \
            _Pragma("unroll") for (int r = 0; r < 16; ++r) { const int kk_ = kb_ + (r & 3) + 8 * (r >> 2); if (kk_ > qrow) c0[r] = 0.f; if (kk_ + 32 > qrow) c1[r] = 0.f; } } \
        float sa_ = 0.f, sb_ = 0.f; \
        _Pragma("unroll") for (int r = 0; r < 16; ++r) { sa_ += c0[r]; sb_ += c1[r]; } \
        l += sa_ + sb_; \
        _Pragma("unroll") for (int j = 0; j < 4; ++j) { \
            PWN[0][j] = cvtpk(c0[2 * j], c0[2 * j + 1]); PWN[1][j] = cvtpk(c0[8 + 2 * j], c0[8 + 2 * j + 1]); \
            PWN[2][j] = cvtpk(c1[2 * j], c1[2 * j + 1]); PWN[3][j] = cvtpk(c1[8 + 2 * j], c1[8 + 2 * j + 1]); } \
        ATT_SBAR(); } while (0)
#define ATT_PV(PWP, tt) do { const ALAS unsigned char* Vb = lds + ((tt) & 3) * 16384 + vro; s16x4 va[8], vb[8]; \
        ATT_VLOAD(va, 0); ATT_VLOAD(vb, 1); ATT_SBAR(); \
        _Pragma("unroll") for (int ks = 0; ks < 4; ++ks) o[0] = ATT_MF(ATT_VF(va, ks), ATT_PWB(PWP, ks), o[0]); \
        ATT_SBAR(); ATT_VLOAD(va, 2); ATT_SBAR(); \
        _Pragma("unroll") for (int ks = 0; ks < 4; ++ks) o[1] = ATT_MF(ATT_VF(vb, ks), ATT_PWB(PWP, ks), o[1]); \
        ATT_SBAR(); ATT_VLOAD(vb, 3); ATT_SBAR(); \
        _Pragma("unroll") for (int ks = 0; ks < 4; ++ks) o[2] = ATT_MF(ATT_VF(va, ks), ATT_PWB(PWP, ks), o[2]); \
        _Pragma("unroll") for (int ks = 0; ks < 4; ++ks) o[3] = ATT_MF(ATT_VF(vb, ks), ATT_PWB(PWP, ks), o[3]); \
        ATT_SBAR(); } while (0)
#define ATT_GAP(MFS, X, B, WORD) do { MFS; X[B] = ATT_EX(X[B]); X[(B) + 1] = ATT_EX(X[(B) + 1]); sacc += X[B]; sacc += X[(B) + 1]; WORD = cvtpk(X[B], X[(B) + 1]); ATT_PIN(sacc); ATT_SBAR(); } while (0)
#define ATT_PV_FUSED(PWP, PWN, t) do { const ALAS unsigned char* Vb = lds + (((t) - 1) & 3) * 16384 + vro; s16x4 va[8], vb[8]; float sacc = 0.f; \
        ATT_VLOAD(va, 0); ATT_VLOAD(vb, 1); ATT_SBAR(); \
        ATT_GAP(o[0] = ATT_MF(ATT_VF(va, 0), ATT_PWB(PWP, 0), o[0]), c0, 0, PWN[0][0]);  ATT_GAP(o[0] = ATT_MF(ATT_VF(va, 1), ATT_PWB(PWP, 1), o[0]), c0, 2, PWN[0][1]); \
        ATT_GAP(o[0] = ATT_MF(ATT_VF(va, 2), ATT_PWB(PWP, 2), o[0]), c0, 4, PWN[0][2]);  ATT_GAP(o[0] = ATT_MF(ATT_VF(va, 3), ATT_PWB(PWP, 3), o[0]), c0, 6, PWN[0][3]); \
        ATT_VLOAD(va, 2); ATT_SBAR(); \
        ATT_GAP(o[1] = ATT_MF(ATT_VF(vb, 0), ATT_PWB(PWP, 0), o[1]), c0, 8, PWN[1][0]);  ATT_GAP(o[1] = ATT_MF(ATT_VF(vb, 1), ATT_PWB(PWP, 1), o[1]), c0, 10, PWN[1][1]); \
        ATT_GAP(o[1] = ATT_MF(ATT_VF(vb, 2), ATT_PWB(PWP, 2), o[1]), c0, 12, PWN[1][2]); ATT_GAP(o[1] = ATT_MF(ATT_VF(vb, 3), ATT_PWB(PWP, 3), o[1]), c0, 14, PWN[1][3]); \
        ATT_VLOAD(vb, 3); ATT_SBAR(); \
        ATT_GAP(o[2] = ATT_MF(ATT_VF(va, 0), ATT_PWB(PWP, 0), o[2]), c1, 0, PWN[2][0]);  ATT_GAP(o[2] = ATT_MF(ATT_VF(va, 1), ATT_PWB(PWP, 1), o[2]), c1, 2, PWN[2][1]); \
        ATT_GAP(o[2] = ATT_MF(ATT_VF(va, 2), ATT_PWB(PWP, 2), o[2]), c1, 4, PWN[2][2]);  ATT_GAP(o[2] = ATT_MF(ATT_VF(va, 3), ATT_PWB(PWP, 3), o[2]), c1, 6, PWN[2][3]); \
        ATT_GAP(o[3] = ATT_MF(ATT_VF(vb, 0), ATT_PWB(PWP, 0), o[3]), c1, 8, PWN[3][0]);  ATT_GAP(o[3] = ATT_MF(ATT_VF(vb, 1), ATT_PWB(PWP, 1), o[3]), c1, 10, PWN[3][1]); \
        ATT_GAP(o[3] = ATT_MF(ATT_VF(vb, 2), ATT_PWB(PWP, 2), o[3]), c1, 12, PWN[3][2]); ATT_GAP(o[3] = ATT_MF(ATT_VF(vb, 3), ATT_PWB(PWP, 3), o[3]), c1, 14, PWN[3][3]); \
        l += sacc; } while (0)
#ifndef ATT_PROBE
#define ATT_PROBE 0
#endif
#if ATT_PROBE == 1
#define ATT_PROBE_CODE(t) do { const ALAS unsigned char* Kb = lds + ((t) & 3) * 32768 + kq0; bf16x8 kx = *(const ALAS bf16x8*)(Kb); f32x16 x0 = zero16, x1 = zero16; \
        _Pragma("unroll") for (int d0_ = 0; d0_ < 4; ++d0_) { x0 = ATT_MF(kx, qf[d0_], x0); x1 = ATT_MF(kx, qf[d0_], x1); } asm volatile("" :: "v"(x0), "v"(x1)); ATT_SBAR(); } while (0)
#elif ATT_PROBE == 2
#define ATT_PROBE_CODE(t) do { f32x16 x0 = c0, x1 = c1; _Pragma("unroll") for (int r = 0; r < 16; ++r) { x0[r] = ATT_EX(x0[r]); x1[r] = ATT_EX(x1[r]); } asm volatile("" :: "v"(x0), "v"(x1)); ATT_SBAR(); } while (0)
#elif ATT_PROBE == 3
#define ATT_PROBE_CODE(t) do { const ALAS unsigned char* Vb = lds + (((t) - 1) & 3) * 32768 + vro; const ALAS unsigned char* Kb = lds + ((t) & 3) * 32768 + kq0; s16x4 xa[8], xb_[8]; ATT_VLOAD(xa, 0); ATT_VLOAD(xb_, 1); \
        bf16x8 kx[8]; _Pragma("unroll") for (int i_ = 0; i_ < 8; ++i_) kx[i_] = *(const ALAS bf16x8*)(Kb + (i_ >> 1) * 2048 + (i_ & 1) * 512); \
        _Pragma("unroll") for (int i_ = 0; i_ < 8; ++i_) asm volatile("" :: "v"(xa[i_]), "v"(xb_[i_]), "v"(kx[i_])); ATT_SBAR(); } while (0)
#elif ATT_PROBE == 4
#define ATT_PROBE_CODE(t) do { asm volatile("s_waitcnt lgkmcnt(0)\n\ts_barrier" ::: "memory"); } while (0)
#else
#define ATT_PROBE_CODE(t) do { } while (0)
#endif
#define ATT_STEPX(PWP, PWN, t) do { \
        if ((t) < tlast) { ATT_QK(t); ATT_PROBE_CODE(t); ATT_PV_FUSED(PWP, PWN, t); } \
        else if ((t) == tlast) { ATT_QK(t); ATT_PV(PWP, (t) - 1); ATT_SOFTMAX(PWN, t); } \
        else if ((t) == tlast + 1) { ATT_PV(PWP, (t) - 1); } } while (0)
    f32x16 c0, c1;
    u32x4 pwa[4], pwb[4];
#pragma unroll
    for (int j = 0; j < 4; ++j) { pwa[j] = (u32x4){0u, 0u, 0u, 0u}; pwb[j] = (u32x4){0u, 0u, 0u, 0u}; }
    if (NT > 2) { ATT_DMAK(2); ATT_DMAK(3); }
    ATT_DMAV(1); if (NT > 2) { ATT_DMAV(2); }
    ATT_QK(0); ATT_SOFTMAX(pwa, 0);
    ATT_STEPX(pwa, pwb, 1);
    ATT_WAIT_BAR(0);
    int t = 2;
    for (; t + 5 <= NT; t += 2) {
        ATT_QKH(t, do { ATT_DMAK(t + 2); ATT_DMAK(t + 3); } while (0), do { ATT_DMAV(t + 1); ATT_DMAV(t + 2); } while (0)); ATT_PV_FUSED(pwb, pwa, t);
        ATT_QK(t + 1); ATT_PV_FUSED(pwa, pwb, t + 1);
        ATT_WAIT_BAR(0);
    }
    for (; t < NT; t += 2) {
        if (t + 2 < NT) { ATT_DMAK(t + 2); ATT_DMAK(t + 3); }
        ATT_DMAV(t + 1); if (t + 2 < NT) { ATT_DMAV(t + 2); }
        ATT_STEPX(pwb, pwa, t); ATT_STEPX(pwa, pwb, t + 1);
        ATT_WAIT_BAR(0);
    }
    if (tlast == NT - 1) { ATT_PV(pwb, NT - 1); }
    ATT_WAIT_BAR(0);
    l += __shfl_xor(l, 32);
    const float inv = 1.0f / l;
    ALAS float* xb = (ALAS float*)(lds + g * 16384);
    if (m == 1) {
        const float f = inv * lam;
#pragma unroll
        for (int db = 0; db < 4; ++db)
#pragma unroll
            for (int r = 0; r < 16; ++r) xb[(32 * db + crow(r, hi)) * 32 + r32] = o[db][r] * f;
    }
    __syncthreads();
    if (m == 0) {
        float ssq = 0.f;
#pragma unroll
        for (int db = 0; db < 4; ++db)
#pragma unroll
            for (int r = 0; r < 16; ++r) { const float v = o[db][r] * inv - xb[(32 * db + crow(r, hi)) * 32 + r32]; o[db][r] = v; ssq += v * v; }
        ssq += __shfl_xor(ssq, 32);
        const float rn = __builtin_amdgcn_rsqf(ssq * (1.0f / 128.0f) + EPS) * oscale;
        bf16_t* op = A2 + (size_t)qrow * DMODEL + h * 128;
#pragma unroll
        for (int db = 0; db < 4; ++db)
#pragma unroll
            for (int rq = 0; rq < 4; ++rq) {
                const int d = 32 * db + 8 * rq + 4 * hi;
                const f32x4 gv = *(const f32x4*)(ogain + d);
                u32x2 w; w.x = cvtpk(o[db][4 * rq] * rn * gv[0], o[db][4 * rq + 1] * rn * gv[1]); w.y = cvtpk(o[db][4 * rq + 2] * rn * gv[2], o[db][4 * rq + 3] * rn * gv[3]);
                *(u32x2*)(op + d) = w;
            }
    }
    __syncthreads();
}

__device__ __forceinline__ void unpack8(const u32x4 w, float (&f)[8]) {
    f[0] = __uint_as_float(w.x << 16); f[1] = __uint_as_float(w.x & 0xffff0000u); f[2] = __uint_as_float(w.y << 16); f[3] = __uint_as_float(w.y & 0xffff0000u);
    f[4] = __uint_as_float(w.z << 16); f[5] = __uint_as_float(w.z & 0xffff0000u); f[6] = __uint_as_float(w.w << 16); f[7] = __uint_as_float(w.w & 0xffff0000u);
}
__device__ __forceinline__ void conv_phase(const bf16_t* __restrict__ z, bf16_t* __restrict__ A2, const float* __restrict__ cw, const float* __restrict__ cb, const float* __restrict__ cgn,
                                           int gwave, int ngw, int lane) {
    const int c0 = lane * 8;
    float w0[8], w1[8], w2[8], bb[8], gg[8];
#pragma unroll
    for (int j = 0; j < 8; ++j) { w0[j] = cw[c0 + j]; w1[j] = cw[512 + c0 + j]; w2[j] = cw[1024 + c0 + j]; bb[j] = cb[c0 + j]; gg[j] = cgn[c0 + j]; }
    for (int task = gwave; task < SEQ / 8; task += ngw) {
        const int t0 = task * 8;
        float u1[8], u2[8];
#pragma unroll
        for (int j = 0; j < 8; ++j) { u1[j] = 0.f; u2[j] = 0.f; }
        if (t0 >= 2) {
            float a[8], b[8];
            unpack8(*(const u32x4*)(z + (size_t)(t0 - 2) * ZP + 2048 + c0), a); unpack8(*(const u32x4*)(z + (size_t)(t0 - 2) * ZP + 2560 + c0), b);
#pragma unroll
            for (int j = 0; j < 8; ++j) u2[j] = a[j] * b[j];
            unpack8(*(const u32x4*)(z + (size_t)(t0 - 1) * ZP + 2048 + c0), a); unpack8(*(const u32x4*)(z + (size_t)(t0 - 1) * ZP + 2560 + c0), b);
#pragma unroll
            for (int j = 0; j < 8; ++j) u1[j] = a[j] * b[j];
        }
        u32x4 GB[8], GC[8], HC[8];
#pragma unroll
        for (int tt = 0; tt < 8; ++tt) { const size_t ro = (size_t)(t0 + tt) * ZP; GB[tt] = *(const u32x4*)(z + ro + 1536 + c0); GC[tt] = *(const u32x4*)(z + ro + 2048 + c0); HC[tt] = *(const u32x4*)(z + ro + 2560 + c0); }
#pragma unroll
        for (int tt = 0; tt < 8; ++tt) {
            float gb[8], gc[8], hc[8], y[8];
            unpack8(GB[tt], gb); unpack8(GC[tt], gc); unpack8(HC[tt], hc);
            float ss = 0.f;
#pragma unroll
            for (int j = 0; j < 8; ++j) { const float u = gc[j] * hc[j]; y[j] = gb[j] * (w0[j] * u2[j] + w1[j] * u1[j] + w2[j] * u + bb[j]); ss += y[j] * y[j]; u2[j] = u1[j]; u1[j] = u; }
            ss += __shfl_xor(ss, 1); ss += __shfl_xor(ss, 2); ss += __shfl_xor(ss, 4);
            const float rn = __builtin_amdgcn_rsqf(ss * (1.0f / 64.0f) + EPS);
            u32x4 w;
            w.x = cvtpk(y[0] * rn * gg[0], y[1] * rn * gg[1]); w.y = cvtpk(y[2] * rn * gg[2], y[3] * rn * gg[3]);
            w.z = cvtpk(y[4] * rn * gg[4], y[5] * rn * gg[5]); w.w = cvtpk(y[6] * rn * gg[6], y[7] * rn * gg[7]);
            *(u32x4*)(A2 + (size_t)(t0 + tt) * DMODEL + 512 + c0) = w;
        }
    }
}
}

#define LAS __attribute__((address_space(3)))
typedef unsigned short bf16;
typedef unsigned v4u __attribute__((ext_vector_type(4)));
typedef float f32x4 __attribute__((ext_vector_type(4)));
constexpr int NWAVES = 8;
#ifndef PHMASK
#define PHMASK 0xFFFF
#endif
#ifndef RUNMASK
#define RUNMASK 0xFFFFu
#endif
constexpr int M = 16384, D = 1024, FF = 2816, NIN = 3072, DPLE = 256, DEPTH = 2;
constexpr int LDS_BYTES = 147456;
constexpr size_t LW = 45613056;
constexpr size_t OW_GU1 = 0, OW_D1 = 11534336, OW_IN = 17301504, OW_OUT = 23592960, OW_GU2 = 25690112, OW_D2 = 37224448, OW_PG = 42991616, OW_PP = 45088768;
constexpr size_t WS_PB = 2 * LW;
constexpr size_t WS_XB = WS_PB + 16777216;
constexpr size_t WS_SSA = WS_XB + 33554432, WS_SSB = WS_SSA + 1048576;
constexpr size_t WS_A2 = WS_SSB + 1048576;
constexpr size_t WS_Z = WS_A2 + 33554432;
constexpr size_t WS_END = WS_Z + 100663296;

__device__ __forceinline__ unsigned f2bf(float f) { unsigned u = __builtin_bit_cast(unsigned, f); return (u + 0x7fffu + ((u >> 16) & 1u)) >> 16; }
__device__ __forceinline__ unsigned pk2(float lo, float hi) { return f2bf(lo) | (f2bf(hi) << 16); }
__device__ __forceinline__ float wave_sum(float v) {
#pragma unroll
    for (int o = 1; o < 64; o <<= 1) v += __shfl_xor(v, o);
    return v;
}
__device__ __forceinline__ float wave_max(float v) {
#pragma unroll
    for (int o = 1; o < 64; o <<= 1) v = fmaxf(v, __shfl_xor(v, o));
    return v;
}
__device__ __forceinline__ void tr_item(const float* __restrict__ W, int K, int N, bf16* __restrict__ WT, int mode, const float* __restrict__ gain, LAS float* scr, int item, int lane) {
    const int nblk = N / 32, kb = item / nblk, nb = item % nblk, k0 = 64 * kb, n0 = 32 * nb;
    float wv[32];
#pragma unroll
    for (int i = 0; i < 32; ++i) { const int kk = 2 * i + (lane >> 5); wv[i] = __builtin_nontemporal_load(W + (size_t)(k0 + kk) * N + n0 + (lane & 31)); }
    if (gain) {
#pragma unroll
        for (int i = 0; i < 32; ++i) wv[i] *= gain[k0 + 2 * i + (lane >> 5)];
    }
#pragma unroll
    for (int i = 0; i < 32; ++i) scr[(2 * i + (lane >> 5)) * 33 + (lane & 31)] = wv[i];
    asm volatile("s_waitcnt lgkmcnt(0)" ::: "memory");
    int rb = n0;
    if (mode == 1) rb = 256 * (n0 >> 7) + (n0 & 127);
    else if (mode == 2) rb = 256 * (n0 >> 7) + 128 + (n0 & 127);
    else if (mode == 3) rb = (n0 & ~255) + 128 * ((n0 >> 5) & 1) + 32 * ((n0 >> 6) & 3);
    const int c = lane & 7;
#pragma unroll
    for (int j = 0; j < 4; ++j) { const int n = (lane >> 3) + 8 * j; const LAS float* s = scr + (8 * c) * 33 + n;
        v4u o; o.x = pk2(s[0 * 33], s[1 * 33]); o.y = pk2(s[2 * 33], s[3 * 33]); o.z = pk2(s[4 * 33], s[5 * 33]); o.w = pk2(s[6 * 33], s[7 * 33]);
        *(v4u*)(WT + (size_t)(rb + n) * K + k0 + 8 * c) = o; }
    asm volatile("s_waitcnt lgkmcnt(0)" ::: "memory");
}

#define XB_TMO      128
#define XB_XCNT(j)  (256  + 64 * (j))
#define XB_XSUB(j)  (1280 + 64 * (j))
#define XB_XGEN(j)  (2304 + 64 * (j))
#define XB_TOP      3328
#define XB_TOPGEN   3392
#define XCD_BAR_WORDS 3456
#define XB_SPIN_CAP (1u << 20)

__device__ __forceinline__ unsigned xb_ld(unsigned* p)              { return __hip_atomic_load(p, __ATOMIC_RELAXED, __HIP_MEMORY_SCOPE_AGENT); }
__device__ __forceinline__ unsigned xb_add(unsigned* p, unsigned v) { return __hip_atomic_fetch_add(p, v, __ATOMIC_RELAXED, __HIP_MEMORY_SCOPE_AGENT); }
__device__ __forceinline__ unsigned xb_xcc_id() { return (unsigned)__builtin_amdgcn_s_getreg((3 << 11) | 20) & 0xFu; }
#define XB_SPIN(cond, bar) do { unsigned _sp = 0; while (cond) { __builtin_amdgcn_s_sleep(1); \
    if ((++_sp & 255u) == 0u) { if (xb_ld(&(bar)[XB_TMO])) break; if (_sp > XB_SPIN_CAP) { atomicAdd(&(bar)[XB_TMO], 1u); break; } } } } while (0)

struct XcdBarrier {
    unsigned* bar; unsigned x;
    volatile LAS unsigned* st;
};

__device__ __forceinline__ XcdBarrier xcd_barrier_post(unsigned* bar, volatile LAS unsigned* st) {
    XcdBarrier b; b.bar = bar; b.x = xb_xcc_id(); b.st = st;
    if (threadIdx.x == 0) (void)xb_add(&bar[XB_XCNT(b.x)], 1u);
    return b;
}
__device__ __forceinline__ void xcd_barrier_complete(unsigned* bar, unsigned x, unsigned& nloc, unsigned& nx) {
    const unsigned G = gridDim.x * gridDim.y * gridDim.z;
    unsigned sum, cnt, mine, sp = 0u;
    for (;;) {
        sum = 0u; cnt = 0u; mine = 0u;
#pragma unroll
        for (unsigned j = 0; j < 16; ++j) { const unsigned c = xb_ld(&bar[XB_XCNT(j)]); sum += c; cnt += (c > 0u) ? 1u : 0u; mine = (j == x) ? c : mine; }
        if (sum == G) break;
        __builtin_amdgcn_s_sleep(1);
        if ((++sp & 255u) == 0u) { if (xb_ld(&bar[XB_TMO])) break; if (sp > XB_SPIN_CAP) { atomicAdd(&bar[XB_TMO], 1u); break; } }
    }
    nloc = mine > 0u ? mine : 1u; nx = cnt > 0u ? cnt : 1u;
}

__device__ __forceinline__ void xcd_barrier(const XcdBarrier& b) {
    asm volatile("s_waitcnt vmcnt(0)" ::: "memory");
    __syncthreads();
    if (threadIdx.x == 0) {
        unsigned* bar = b.bar;
        __builtin_amdgcn_s_waitcnt(0);
        unsigned nloc = b.st[0], nx = b.st[1];
        if (nloc == 0u) { xcd_barrier_complete(bar, b.x, nloc, nx); b.st[0] = nloc; b.st[1] = nx; }
        const unsigned old = xb_add(&bar[XB_XSUB(b.x)], 1u);
        const unsigned gen = old / nloc;
        if (old + 1u == (gen + 1u) * nloc) {
            __builtin_amdgcn_fence(__ATOMIC_RELEASE, "agent");
            asm volatile("s_waitcnt vmcnt(0)" ::: "memory");
            const unsigned og = xb_add(&bar[XB_TOP], 1u);
            const unsigned tg = og / nx;
            if (og + 1u == (tg + 1u) * nx) xb_add(&bar[XB_TOPGEN], 1u);
            else XB_SPIN(xb_ld(&bar[XB_TOPGEN]) == tg, bar);
            __builtin_amdgcn_fence(__ATOMIC_ACQUIRE, "agent");
            xb_add(&bar[XB_XGEN(b.x)], 1u);
            asm volatile("s_waitcnt vmcnt(0)" ::: "memory");
        } else {
            XB_SPIN(xb_ld(&bar[XB_XGEN(b.x)]) == gen, bar);
            __builtin_amdgcn_fence(__ATOMIC_ACQUIRE, "agent");
            asm volatile("s_waitcnt vmcnt(0)" ::: "memory");
        }
    }
    __syncthreads();
}

constexpr size_t WS_BAR = WS_END;
constexpr int MISC_OFF = 131072 + 512;
#define CONVERT_ITEMS(Lc, it0, it1, gwx, ngwx) do { \
        bf16* wlc = (bf16*)(ws + (size_t)(Lc) * LW); const size_t oF = (size_t)(Lc) * D * FF, oS = (size_t)(Lc) * D * D; \
        for (int it = (it0) + (gwx); it < (it1); it += (ngwx)) { \
            int r = it; \
            if (r < I_F) { tr_item(KA->in[3] + oF, D, FF, (bf16*)((unsigned char*)wlc + OW_GU1), 1, KA->in[2] + (Lc) * D, scr, r, lane); continue; } r -= I_F; \
            if (r < I_F) { tr_item(KA->in[4] + oF, D, FF, (bf16*)((unsigned char*)wlc + OW_GU1), 2, KA->in[2] + (Lc) * D, scr, r, lane); continue; } r -= I_F; \
            if (r < I_F) { tr_item(KA->in[5] + oF, FF, D, (bf16*)((unsigned char*)wlc + OW_D1), 0, nullptr, scr, r, lane); continue; } r -= I_F; \
            if (r < I_IN) { tr_item(KA->in[7] + (size_t)(Lc) * D * NIN, D, NIN, (bf16*)((unsigned char*)wlc + OW_IN), 3, KA->in[6] + (Lc) * D, scr, r, lane); continue; } r -= I_IN; \
            if (r < I_SQ) { tr_item(KA->in[18] + oS, D, D, (bf16*)((unsigned char*)wlc + OW_OUT), 0, nullptr, scr, r, lane); continue; } r -= I_SQ; \
            if (r < I_F) { tr_item(KA->in[20] + oF, D, FF, (bf16*)((unsigned char*)wlc + OW_GU2), 1, KA->in[19] + (Lc) * D, scr, r, lane); continue; } r -= I_F; \
            if (r < I_F) { tr_item(KA->in[21] + oF, D, FF, (bf16*)((unsigned char*)wlc + OW_GU2), 2, KA->in[19] + (Lc) * D, scr, r, lane); continue; } r -= I_F; \
            if (r < I_F) { tr_item(KA->in[22] + oF, FF, D, (bf16*)((unsigned char*)wlc + OW_D2), 0, nullptr, scr, r, lane); continue; } r -= I_F; \
            if (r < I_SQ) { tr_item(KA->in[24] + oS, D, D, (bf16*)((unsigned char*)wlc + OW_PG), 0, KA->in[23] + (Lc) * D, scr, r, lane); continue; } r -= I_SQ; \
            tr_item(KA->in[25] + (size_t)(Lc) * DPLE * D, DPLE, D, (bf16*)((unsigned char*)wlc + OW_PP), 0, nullptr, scr, r, lane); \
        } } while (0)
constexpr int I_F = 1408, I_IN = 1536, I_SQ = 512, I_PP = 128;
constexpr int ITEMS = 6 * I_F + I_IN + 2 * I_SQ + I_PP;
constexpr int ITEMS_GU1 = 2 * I_F;
constexpr int ITEMS_SPLIT = 7424;
struct Args { const float* in[26]; float* out; unsigned char* ws; unsigned mask; unsigned pad; };
typedef const __attribute__((address_space(4))) Args* KP;
#define KARGS() ((KP)__builtin_amdgcn_kernarg_segment_ptr())
#define PH_BEGIN KP KA = KARGS(); int Ll = L, Gl = G, bxl = bx, tidl = threadIdx.x; asm volatile("" : "+s"(KA), "+s"(Ll), "+s"(Gl), "+s"(bxl), "+v"(tidl)); unsigned char* ws = KA->ws; float* X = KA->out; \
    const int lane = tidl & 63, wave = __builtin_amdgcn_readfirstlane(tidl >> 6), vcu = (Gl % 8 == 0) ? (bxl % 8) * (Gl / 8) + bxl / 8 : bxl, gw = vcu * NWAVES + wave, NGW = Gl * NWAVES; (void)lane; (void)gw; (void)NGW; \
    const unsigned char* wl = ws + (size_t)Ll * LW; (void)wl; (void)Gl; (void)bxl; (void)X;
#define WPTR(off) ((const bf16*)(wl + (off)))
#define XB ((bf16*)(ws + WS_XB))
#define XB4 ((bf16*)(ws))
#define SSA ((float*)(ws + WS_SSA))
#define SSB ((float*)(ws + WS_SSB))
#define A2 ((bf16*)(ws + WS_A2))
#define Z ((bf16*)(ws + WS_Z))
#define PB ((bf16*)(ws + WS_PB))
#define Hb Z


__global__ void __launch_bounds__(NWAVES * 64, 2) fwd_mega(Args a) {
    extern __shared__ __attribute__((aligned(16))) unsigned char lds_raw[];
    LAS unsigned char* lds = (LAS unsigned char*)lds_raw;
    cg::grid_group grid = cg::this_grid();
    const int G = gridDim.x, bx = blockIdx.x;
    if (threadIdx.x < 2) ((volatile LAS unsigned*)(lds + MISC_OFF))[threadIdx.x] = 0u;
    if (threadIdx.x == 0) (void)xb_add((unsigned*)(KARGS()->ws + WS_BAR) + XB_XCNT(xb_xcc_id()), 1u);
#define GRID_BAR() do { XcdBarrier b_; b_.bar = (unsigned*)(KARGS()->ws + WS_BAR); b_.x = xb_xcc_id(); b_.st = (volatile LAS unsigned*)(lds + MISC_OFF); xcd_barrier(b_); } while (0)

#ifndef REP_P0
#define REP_P0 1
#endif
#ifndef REP_S1
#define REP_S1 1
#endif
#ifndef REP_S2
#define REP_S2 1
#endif
#ifndef REP_S3
#define REP_S3 1
#endif
#ifndef REP_S5
#define REP_S5 1
#endif
#ifndef REP_S8
#define REP_S8 1
#endif
    for (int rep = 0; rep < REP_P0; ++rep)
    if ((PHMASK & 1) && (KARGS()->mask & 1u)) {
        const int L = 0; PH_BEGIN (void)Ll;
        LAS float* scr = (LAS float*)(lds + wave * 16384);
        CONVERT_ITEMS(0, 0, ITEMS_GU1, gw, NGW);
        if (Gl != 256) { CONVERT_ITEMS(0, ITEMS_GU1, ITEMS, gw, NGW); CONVERT_ITEMS(1, 0, ITEMS, gw, NGW); }
        const float* xin = KA->in[0];
        for (int row = gw; row < M; row += NGW) {
            const f32x4* xr = (const f32x4*)(xin + (size_t)row * D) + lane;
            f32x4 v[4]; float s = 0.f;
#pragma unroll
            for (int j = 0; j < 4; ++j) { v[j] = xr[64 * j]; s += (v[j][0] * v[j][0] + v[j][1] * v[j][1]) + (v[j][2] * v[j][2] + v[j][3] * v[j][3]); }
            s = wave_sum(s);
            unsigned long long* o8 = (unsigned long long*)(XB + (size_t)row * D) + lane;
#pragma unroll
            for (int j = 0; j < 4; ++j) o8[64 * j] = (unsigned long long)pk2(v[j][0], v[j][1]) | ((unsigned long long)pk2(v[j][2], v[j][3]) << 32);
            if (lane < 16) SSB[(size_t)row * 16 + lane] = (lane == 0) ? s : 0.f;
        }
        const float* pin = KA->in[1];
        for (size_t i = (size_t)(bxl * (NWAVES * 64) + tidl) * 8; i < (size_t)DEPTH * M * DPLE; i += (size_t)Gl * NWAVES * 64 * 8) {
            const f32x4 v0 = *(const f32x4*)(pin + i), v1 = *(const f32x4*)(pin + i + 4);
            v4u o; o.x = pk2(v0[0], v0[1]); o.y = pk2(v0[2], v0[3]); o.z = pk2(v1[0], v1[1]); o.w = pk2(v1[2], v1[3]);
            *(v4u*)(PB + i) = o;
        }
    }
    GRID_BAR();
    if (KARGS()->mask == 0xC0FFEE11u) grid.sync();

#pragma unroll 1
    for (int L = 0; L < DEPTH; ++L) {
        for (int rep = 0; rep < REP_S1; ++rep)
        if ((PHMASK & 2) && (KARGS()->mask & 2u)) { PH_BEGIN pg8::Gemm g{Ll == 0 ? XB : XB4, WPTR(OW_GU1), M, 2 * FF, D}; pg8::StaticOrder S; S.init(M, 2 * FF, Gl, bxl); pg8::EpiSwiglu E{Hb, SSB};
          pg8::gemm_phase<pg8::EpiSwiglu, pg8::StaticOrder, true, true>(lds, g, S, E);
          if (Gl == 256 && bxl >= 128) { LAS float* scr = (LAS float*)(lds + wave * 16384); CONVERT_ITEMS(Ll, ITEMS_GU1, ITEMS, (bxl - 128) * NWAVES + wave, 128 * NWAVES); } }
        GRID_BAR();
        for (int rep = 0; rep < REP_S2; ++rep)
        if ((PHMASK & 4) && (KARGS()->mask & 4u)) { PH_BEGIN pg8::Gemm g{Hb, WPTR(OW_D1), M, D, FF}; pg8::StaticOrder S; S.init(M, D, Gl, bxl); pg8::EpiResid E{(Ll == 0 && rep == 0) ? KA->in[0] : X, X, XB, SSA, rep == 0 ? 0.5f : 0.0f};
          pg8::gemm_phase<pg8::EpiResid, pg8::StaticOrder, true, true>(lds, g, S, E); }
        GRID_BAR();
        for (int rep = 0; rep < REP_S3; ++rep)
        if ((PHMASK & 8) && (KARGS()->mask & 8u)) { PH_BEGIN pg8::Gemm g{XB, WPTR(OW_IN), M, NIN, D}; pg8::StaticOrder S; S.init(M, NIN, Gl, bxl); pg8::EpiWin E{Z, SSA, KA->in[8] + Ll * 64, KA->in[9] + Ll * 64};
          pg8::gemm_phase<pg8::EpiWin, pg8::StaticOrder, true, true>(lds, g, S, E); }
        GRID_BAR();
        if ((PHMASK & 16) && (KARGS()->mask & 16u)) {
            PH_BEGIN
            att::conv_phase(Z, A2, KA->in[15] + Ll * 3 * 512, KA->in[16] + Ll * 512, KA->in[17] + Ll * 512, gw, NGW, lane);
            const float lam_init = (Ll == 0) ? 0.2f : (0.8f - 0.6f * 0.7408182206817179f);
            const float d1 = wave_sum(KA->in[10][Ll * 64 + lane] * KA->in[11][Ll * 64 + lane]);
            const float d2 = wave_sum(KA->in[12][Ll * 64 + lane] * KA->in[13][Ll * 64 + lane]);
            const float lam = __expf(d1) - __expf(d2) + lam_init;
            const float mq = wave_max(fabsf(KA->in[8][Ll * 64 + lane])), mk = wave_max(fabsf(KA->in[9][Ll * 64 + lane]));
            const float negM = -(64.0f * pg8::QSCALE * mq * mk);
#ifndef REP_ATT
#define REP_ATT 1
#endif
            for (int rep = 0; rep < REP_ATT; ++rep)
            for (int j = vcu; j < 256; j += Gl) {
                const int h = j >> 6, s = j & 63;
#pragma unroll 1
                for (int k2 = 0; k2 < 2; ++k2) att::attn_unit(lds, Z, A2, h, k2 == 0 ? 127 - s : s, negM, lam, KA->in[14] + Ll * 128, 1.0f - lam_init);
            }
        }
        GRID_BAR();
        for (int rep = 0; rep < REP_S5; ++rep)
        if ((PHMASK & 32) && (KARGS()->mask & 32u)) { PH_BEGIN pg8::Gemm g{A2, WPTR(OW_OUT), M, D, D}; pg8::StaticOrder S; S.init(M, D, Gl, bxl); pg8::EpiResid E{X, X, XB, SSB, rep == 0 ? 1.0f : 0.0f};
          pg8::gemm_phase<pg8::EpiResid, pg8::StaticOrder, true, true>(lds, g, S, E); }
        GRID_BAR();
        if ((PHMASK & 64) && (KARGS()->mask & 64u)) { PH_BEGIN pg8::Gemm g{XB, WPTR(OW_GU2), M, 2 * FF, D}; pg8::StaticOrder S; S.init(M, 2 * FF, Gl, bxl); pg8::EpiSwiglu E{Hb, SSB};
          pg8::gemm_phase<pg8::EpiSwiglu, pg8::StaticOrder, true, true>(lds, g, S, E); }
        if ((PHMASK & 128) && (KARGS()->mask & 128u)) { PH_BEGIN int Kp = DPLE; asm volatile("" : "+s"(Kp)); pg8::Gemm g{PB + (size_t)Ll * M * DPLE, WPTR(OW_PP), M, D, Kp}; pg8::StaticOrder S; const bool half_ = (Gl == 256); S.init(M, D, half_ ? 128 : Gl, half_ ? (bxl >= 128 ? bxl - 128 : 1 << 20) : bxl); pg8::EpiPlain E{A2};
          pg8::gemm_phase<pg8::EpiPlain, pg8::StaticOrder, true, true>(lds, g, S, E);
          if (Ll + 1 < DEPTH && Gl == 256 && bxl >= 128) { LAS float* scr = (LAS float*)(lds + wave * 16384); CONVERT_ITEMS(Ll + 1, 0, ITEMS_GU1, (bxl - 128) * NWAVES + wave, 128 * NWAVES); } }
        GRID_BAR();
        if ((PHMASK & 256) && (KARGS()->mask & 256u)) { PH_BEGIN pg8::Gemm g{Hb, WPTR(OW_D2), M, D, FF}; pg8::StaticOrder S; S.init(M, D, Gl, bxl); pg8::EpiResid E{X, X, XB, SSA, 0.5f};
          pg8::gemm_phase<pg8::EpiResid, pg8::StaticOrder, true, true>(lds, g, S, E); }
        GRID_BAR();
        for (int rep = 0; rep < REP_S8; ++rep)
        if ((PHMASK & 512) && (KARGS()->mask & 512u)) { PH_BEGIN pg8::Gemm g{XB, WPTR(OW_PG), M, D, D}; pg8::StaticOrder S; S.init(M, D, Gl, bxl); pg8::EpiPle E{X, XB4, SSA, SSB, A2, rep == 0 ? 1.0f : 0.0f, Ll + 1 < DEPTH};
          pg8::gemm_phase<pg8::EpiPle, pg8::StaticOrder, true, true>(lds, g, S, E); }
        if (L + 1 < DEPTH) GRID_BAR();
    }
}

extern "C" void kernel_launch(void* const* d_in, const int* in_sizes, int n_in, void* d_out, int out_size, void* d_ws, size_t ws_size, hipStream_t stream) {
    static int grid = 0;
    if (grid == 0) {
        if (n_in != 26 || out_size != M * D || ws_size < WS_END + 16384) { fprintf(stderr, "kernel_launch: unexpected shapes (n_in %d, out %d, ws %zu < %zu)\n", n_in, out_size, ws_size, (size_t)WS_END); grid = -1; return; }
        int dev = 0, cus = 0, per_cu = 0;
        hipGetDevice(&dev);
        hipDeviceGetAttribute(&cus, hipDeviceAttributeMultiprocessorCount, dev);
        if (hipFuncSetAttribute((const void*)fwd_mega, hipFuncAttributeMaxDynamicSharedMemorySize, LDS_BYTES) != hipSuccess) { fprintf(stderr, "kernel_launch: hipFuncSetAttribute failed\n"); grid = -1; return; }
        if (hipOccupancyMaxActiveBlocksPerMultiprocessor(&per_cu, (const void*)fwd_mega, NWAVES * 64, LDS_BYTES) != hipSuccess || per_cu < 1) { fprintf(stderr, "kernel_launch: occupancy query gave %d\n", per_cu); per_cu = 1; }
        (void)hipGetLastError();
        grid = cus;
    }
    if (grid < 0) return;
    Args a{};
    for (int i = 0; i < 26; ++i) a.in[i] = (const float*)d_in[i];
    a.out = (float*)d_out; a.ws = (unsigned char*)d_ws; a.mask = RUNMASK; a.pad = 0;
    void* args[] = {&a};
    if (hipMemsetAsync((char*)d_ws + WS_BAR, 0, 16384, stream) != hipSuccess) { fprintf(stderr, "kernel_launch: hipMemsetAsync of the barrier words failed\n"); return; }
    hipError_t e = hipLaunchCooperativeKernel((const void*)fwd_mega, dim3(grid), dim3(NWAVES * 64), args, LDS_BYTES, stream);
    if (e != hipSuccess) fprintf(stderr, "kernel_launch: cooperative launch failed: %s (grid %d)\n", hipGetErrorString(e), grid);
}
```
